# Optimizing an MI355X kernel written in HIP

```python
import jax, jax.numpy as jnp
from jax import lax
import numpy as np

D_MODEL = 1024
BATCH = 2
SEQ = 8192
DEPTH = 2

HEAD_DIM = 64
GROUP_WIDTH = D_MODEL // 4
N_HEADS = GROUP_WIDTH // HEAD_DIM
D_MIX = 4 * GROUP_WIDTH
ROPE_THETA = 500000.0
ROPE_DIM = HEAD_DIM // 4
Q_CHUNK = 128
MOBA_BLOCK = 256
MOBA_TOPK = 3
NSA_KV_DIM = HEAD_DIM
CMP_BLOCK = 32
CMP_STRIDE = 16
CMP_HIDDEN = 128
SLC_BLOCK = 64
SLC_TOPN = 16
WIN = 512
FORCE_SCORE = 1e9
POOL_WINDOWS = (2, 4, 8, 16)
POOL_GROUPS = len(POOL_WINDOWS)
POOL_GDIM = GROUP_WIDTH // POOL_GROUPS
GLA_CHUNK = 64
GLA_LOWRANK = 16
GLA_TAU = 16.0
N_EXPERTS = 256
TOP_K = 8
N_EXPERT_GROUPS = 8
TOPK_GROUPS = 4
D_EXPERT = D_MODEL // 4
D_SHARED = D_EXPERT
ROUTED_SCALE = 2.5
MOE_BLOCK = 128
LN_EPS = 1e-5
DEEPNORM_ALPHA = (2 * DEPTH) ** 0.25
DEEPNORM_BETA = (8 * DEPTH) ** -0.25
IN_LAYOUT = (
    ('moba_q', GROUP_WIDTH), ('moba_k', GROUP_WIDTH), ('moba_v', GROUP_WIDTH),
    ('nsa_q', GROUP_WIDTH),
    ('nsa_k_cmp', NSA_KV_DIM), ('nsa_v_cmp', NSA_KV_DIM),
    ('nsa_k_slc', NSA_KV_DIM), ('nsa_v_slc', NSA_KV_DIM),
    ('nsa_k_win', NSA_KV_DIM), ('nsa_v_win', NSA_KV_DIM),
    ('nsa_gate', 3 * N_HEADS),
    ('pool', GROUP_WIDTH),
    ('gla_q', GROUP_WIDTH), ('gla_k', GROUP_WIDTH), ('gla_v', GROUP_WIDTH),
    ('gla_a', GLA_LOWRANK), ('gla_g', GROUP_WIDTH),
)
IN_COLS = sum(w for _, w in IN_LAYOUT)

kernel_name = 'hybrid_headgroup_moe_deepnorm_block'


def split_columns(z):
    out, start = {}, 0
    for name, width in IN_LAYOUT:
        out[name] = z[..., start:start + width]
        start += width
    return out


def to_heads(t):
    B, T, W = t.shape
    return t.reshape(B, T, W // HEAD_DIM, HEAD_DIM).transpose(0, 2, 1, 3)


def from_heads(t):
    B, H, T, d = t.shape
    return t.transpose(0, 2, 1, 3).reshape(B, T, H * d)


def layer_norm(x, g, b):
    xf = x.astype(jnp.float32)
    mu = jnp.mean(xf, -1, keepdims=True)
    var = jnp.mean(jnp.square(xf - mu), -1, keepdims=True)
    return ((xf - mu) * lax.rsqrt(var + LN_EPS) * g + b).astype(x.dtype)


def partial_rope(x, pos):
    half = ROPE_DIM // 2
    inv_freq = ROPE_THETA ** (-jnp.arange(half, dtype=jnp.float32) / half)
    ang = pos.astype(jnp.float32)[:, None] * inv_freq[None, :]
    cos, sin = jnp.cos(ang), jnp.sin(ang)
    xr = x[..., :ROPE_DIM].astype(jnp.float32)
    x1, x2 = xr[..., :half], xr[..., half:]
    rot = jnp.concatenate([x1 * cos - x2 * sin, x1 * sin + x2 * cos], axis=-1).astype(x.dtype)
    return jnp.concatenate([rot, x[..., ROPE_DIM:]], axis=-1)


def masked_softmax(s, mask):
    s = jnp.where(mask, s, -jnp.inf)
    m = jnp.max(s, -1, keepdims=True)
    m = jnp.where(jnp.isfinite(m), m, 0.0)
    e = jnp.where(mask, jnp.exp(s - m), 0.0)
    return e / jnp.maximum(jnp.sum(e, -1, keepdims=True), 1e-30)


def moba_attention(q, k, v):
    B, H, T, d = q.shape
    n_blk = -(-T // MOBA_BLOCK)
    pad = ((0, 0), (0, 0), (0, n_blk * MOBA_BLOCK - T), (0, 0))
    kb = jnp.pad(k, pad).reshape(B, H, n_blk, MOBA_BLOCK, d)
    vb = jnp.pad(v, pad).reshape(B, H, n_blk, MOBA_BLOCK, d)
    k_mean = jnp.mean(kb.astype(jnp.float32), axis=3)
    k_sel = min(MOBA_TOPK, n_blk)
    n_chunk = T // Q_CHUNK
    scale = d ** -0.5
    gather = jax.vmap(jax.vmap(lambda blocks, idx: blocks[idx]))
    q_chunks = q.reshape(B, H, n_chunk, Q_CHUNK, d).transpose(2, 0, 1, 3, 4)

    def step(args):
        ci, qc = args
        q_pos = ci * Q_CHUNK + jnp.arange(Q_CHUNK)
        own = (ci * Q_CHUNK) // MOBA_BLOCK
        gate = jnp.einsum('bhqd,bhnd->bhqn', qc.astype(jnp.float32), k_mean)
        gate = jnp.where(jnp.arange(n_blk) < own, gate, -jnp.inf)
        _, gidx = lax.top_k(gate, k_sel)
        sel_ok = gidx < own
        k_g = gather(kb, gidx)
        v_g = gather(vb, gidx)
        s_sel = jnp.einsum('bhqd,bhqkpd->bhqkp', qc, k_g).astype(jnp.float32) * scale
        s_sel = jnp.where(sel_ok[..., None], s_sel, -jnp.inf).reshape(B, H, Q_CHUNK, k_sel * MOBA_BLOCK)
        k_own = lax.dynamic_index_in_dim(kb, own, axis=2, keepdims=False)
        v_own = lax.dynamic_index_in_dim(vb, own, axis=2, keepdims=False)
        s_own = jnp.einsum('bhqd,bhpd->bhqp', qc, k_own).astype(jnp.float32) * scale
        k_pos = own * MOBA_BLOCK + jnp.arange(MOBA_BLOCK)
        s_own = jnp.where(k_pos[None, :] <= q_pos[:, None], s_own, -jnp.inf)
        p = jax.nn.softmax(jnp.concatenate([s_sel, s_own], axis=-1), axis=-1).astype(v.dtype)
        p_sel = p[..., :k_sel * MOBA_BLOCK].reshape(B, H, Q_CHUNK, k_sel, MOBA_BLOCK)
        p_own = p[..., k_sel * MOBA_BLOCK:]
        return (jnp.einsum('bhqkp,bhqkpd->bhqd', p_sel, v_g)
                + jnp.einsum('bhqp,bhpd->bhqd', p_own, v_own)).astype(v.dtype)

    out = lax.map(step, (jnp.arange(n_chunk), q_chunks))
    return out.transpose(1, 2, 0, 3, 4).reshape(B, H, T, d)


def compress_blocks(blocks, pe, w1, w2):
    B, n, L, d = blocks.shape
    hid = jax.nn.gelu((blocks + pe).reshape(B, n, L * d) @ w1)
    return hid @ w2


def nsa_attention(q, q_rot, k_cmp, v_cmp, k_slc, v_slc, k_win, v_win, gates, cmp_pe, cmp_w1, cmp_w2):
    B, H, T, d = q.shape
    scale = d ** -0.5
    n_cmp = (T - CMP_BLOCK) // CMP_STRIDE + 1
    cmp_start = jnp.arange(n_cmp) * CMP_STRIDE
    cmp_idx = cmp_start[:, None] + jnp.arange(CMP_BLOCK)[None, :]
    kc = compress_blocks(k_cmp[:, cmp_idx], cmp_pe[0], cmp_w1[0], cmp_w2[0])
    vc = compress_blocks(v_cmp[:, cmp_idx], cmp_pe[1], cmp_w1[1], cmp_w2[1])
    cmp_end = cmp_start + CMP_BLOCK - 1
    n_slc = T // SLC_BLOCK
    n_sel = min(SLC_TOPN, n_slc)
    slc_start = jnp.arange(n_slc) * SLC_BLOCK
    overlap = ((cmp_start[:, None] < slc_start[None, :] + SLC_BLOCK)
               & (cmp_start[:, None] + CMP_BLOCK > slc_start[None, :])).astype(jnp.float32)
    ks_blk = k_slc.reshape(B, n_slc, SLC_BLOCK, d)
    vs_blk = v_slc.reshape(B, n_slc, SLC_BLOCK, d)
    kw_pad = jnp.pad(k_win, ((0, 0), (WIN, 0), (0, 0)))
    vw_pad = jnp.pad(v_win, ((0, 0), (WIN, 0), (0, 0)))
    gather = jax.vmap(lambda blocks, idx: blocks[idx])
    n_chunk = T // Q_CHUNK

    def chunks(t):
        return t.reshape(B, H, n_chunk, Q_CHUNK, t.shape[-1]).transpose(2, 0, 1, 3, 4)

    def step(args):
        ci, qc, qrc, gc = args
        q_pos = ci * Q_CHUNK + jnp.arange(Q_CHUNK)
        s_c = jnp.einsum('bhqd,bnd->bhqn', qc, kc).astype(jnp.float32) * scale
        p_c = masked_softmax(s_c, cmp_end[None, :] <= q_pos[:, None])
        o_c = jnp.einsum('bhqn,bnd->bhqd', p_c.astype(vc.dtype), vc)
        imp = jnp.einsum('bhqn,nj->bqj', p_c, overlap)
        cur = q_pos // SLC_BLOCK
        j = jnp.arange(n_slc)
        forced = (j[None, :] == 0) | (j[None, :] == cur[:, None]) | (j[None, :] == cur[:, None] - 1)
        valid = slc_start[None, :] <= q_pos[:, None]
        imp = jnp.where(valid, jnp.where(forced, FORCE_SCORE, imp), -jnp.inf)
        _, sidx = lax.top_k(imp, n_sel)
        k_g = gather(ks_blk, sidx)
        v_g = gather(vs_blk, sidx)
        k_pos = sidx[..., None] * SLC_BLOCK + jnp.arange(SLC_BLOCK)
        s_s = jnp.einsum('bhqd,bqkpd->bhqkp', qrc, k_g).astype(jnp.float32) * scale
        s_s = jnp.where((k_pos <= q_pos[None, :, None, None])[:, None], s_s, -jnp.inf)
        p_s = jax.nn.softmax(s_s.reshape(B, H, Q_CHUNK, -1), axis=-1).reshape(s_s.shape)
        o_s = jnp.einsum('bhqkp,bqkpd->bhqd', p_s.astype(v_g.dtype), v_g)
        kw = lax.dynamic_slice_in_dim(kw_pad, ci * Q_CHUNK, Q_CHUNK + WIN, axis=1)
        vw = lax.dynamic_slice_in_dim(vw_pad, ci * Q_CHUNK, Q_CHUNK + WIN, axis=1)
        w_pos = ci * Q_CHUNK - WIN + jnp.arange(Q_CHUNK + WIN)
        w_mask = ((w_pos[None, :] <= q_pos[:, None]) & (w_pos[None, :] > q_pos[:, None] - WIN)
                  & (w_pos[None, :] >= 0))
        s_w = jnp.einsum('bhqd,bkd->bhqk', qrc, kw).astype(jnp.float32) * scale
        p_w = jax.nn.softmax(jnp.where(w_mask, s_w, -jnp.inf), axis=-1)
        o_w = jnp.einsum('bhqk,bkd->bhqd', p_w.astype(vw.dtype), vw)
        out = gc[..., 0:1] * o_c + gc[..., 1:2] * o_s + gc[..., 2:3] * o_w
        return out.astype(q.dtype)

    out = lax.map(step, (jnp.arange(n_chunk), chunks(q), chunks(q_rot), chunks(gates)))
    return out.transpose(1, 2, 0, 3, 4).reshape(B, H, T, d)


def pool_mixer(u, pool_w, pool_scale):
    B, T, _ = u.shape
    ug = u.astype(jnp.float32).reshape(B, T, POOL_GROUPS, POOL_GDIM)
    cs = jnp.cumsum(ug, axis=1)
    t1 = jnp.arange(1, T + 1, dtype=jnp.float32)
    pooled = []
    for g, w in enumerate(POOL_WINDOWS):
        c_g = cs[:, :, g]
        lagged = jnp.pad(c_g, ((0, 0), (w, 0), (0, 0)))[:, :T]
        count = jnp.minimum(t1, float(w))[None, :, None]
        pooled.append((c_g - lagged) / count)
    pooled = jnp.stack(pooled, axis=2) - ug
    mixed = jnp.einsum('btgc,gcd->btgd', pooled, pool_w.astype(jnp.float32))
    return (mixed.reshape(B, T, GROUP_WIDTH) * pool_scale).astype(u.dtype)


def gla_chunked(q, k, v, log_a):
    B, H, T, dk = q.shape
    dv = v.shape[-1]
    n = T // GLA_CHUNK

    def chunks(t):
        return t.reshape(B, H, n, GLA_CHUNK, t.shape[-1]).transpose(2, 0, 1, 3, 4)

    causal = jnp.tril(jnp.ones((GLA_CHUNK, GLA_CHUNK), bool))[:, :, None]

    def step(S, inp):
        qc, kc, vc, ac = inp
        b = jnp.cumsum(ac, axis=2)
        diff = b[:, :, :, None, :] - b[:, :, None, :, :]
        decay = jnp.where(causal, jnp.exp(jnp.where(causal, diff, 0.0)), 0.0)
        attn = jnp.einsum('bhid,bhjd,bhijd->bhij', qc, kc, decay)
        o = jnp.einsum('bhij,bhjv->bhiv', attn, vc) + jnp.einsum('bhid,bhdv->bhiv', qc * jnp.exp(b), S)
        b_end = b[:, :, -1, :]
        S = jnp.exp(b_end)[..., None] * S + jnp.einsum('bhjd,bhjv->bhdv', kc * jnp.exp(b_end[:, :, None, :] - b), vc)
        return S, o

    S0 = jnp.zeros((B, H, dk, dv), jnp.float32)
    _, o = lax.scan(step, S0, (chunks(q * dk ** -0.5), chunks(k), chunks(v), chunks(log_a)))
    return o.transpose(1, 2, 0, 3, 4).reshape(B, H, T, dv)


def token_mixers(h, w_in, cmp_pe, cmp_w1, cmp_w2, pool_w, pool_scale, gla_wa, gla_ba, gla_norm, w_out):
    B, T, _ = h.shape
    f32 = jnp.float32
    pos = jnp.arange(T)
    p = split_columns(h @ w_in)
    qa = partial_rope(to_heads(p['moba_q']), pos)
    ka = partial_rope(to_heads(p['moba_k']), pos)
    o_a = from_heads(moba_attention(qa, ka, to_heads(p['moba_v'])))
    qb = to_heads(p['nsa_q'])
    gates = jax.nn.sigmoid(p['nsa_gate'].astype(f32)).reshape(B, T, N_HEADS, 3).transpose(0, 2, 1, 3)
    o_b = from_heads(nsa_attention(qb, partial_rope(qb, pos), p['nsa_k_cmp'], p['nsa_v_cmp'],
                                   partial_rope(p['nsa_k_slc'], pos), p['nsa_v_slc'],
                                   partial_rope(p['nsa_k_win'], pos), p['nsa_v_win'],
                                   gates, cmp_pe, cmp_w1, cmp_w2))
    o_c = pool_mixer(p['pool'], pool_w, pool_scale)
    log_a = jax.nn.log_sigmoid((p['gla_a'] @ gla_wa + gla_ba).astype(f32)) / GLA_TAU
    o = gla_chunked(to_heads(p['gla_q']).astype(f32), to_heads(p['gla_k']).astype(f32),
                    to_heads(p['gla_v']).astype(f32), to_heads(log_a))
    o = (o * lax.rsqrt(jnp.mean(o * o, -1, keepdims=True) + LN_EPS) * gla_norm.astype(f32)
         * jax.nn.silu(to_heads(p['gla_g']).astype(f32)))
    o_d = from_heads(o).astype(h.dtype)
    return jnp.concatenate([o_a, o_b, o_c, o_d], axis=-1) @ w_out


def moe_ffn(h, w_router, router_bias, exp_gate, exp_up, exp_down, sh_gate, sh_up, sh_down):
    B, T, D = h.shape
    n_tok = B * T
    xt = h.reshape(n_tok, D)
    s = jax.nn.sigmoid(xt.astype(jnp.float32) @ w_router.astype(jnp.float32))
    s_sel = s + router_bias.astype(jnp.float32)
    grp = s_sel.reshape(n_tok, N_EXPERT_GROUPS, N_EXPERTS // N_EXPERT_GROUPS)
    grp_score = jnp.sum(lax.top_k(grp, 2)[0], axis=-1)
    _, gidx = lax.top_k(grp_score, TOPK_GROUPS)
    gmask = jnp.any(gidx[:, :, None] == jnp.arange(N_EXPERT_GROUPS)[None, None, :], axis=1)
    emask = jnp.repeat(gmask, N_EXPERTS // N_EXPERT_GROUPS, axis=1)
    _, eidx = lax.top_k(jnp.where(emask, s_sel, -jnp.inf), TOP_K)
    wts = jnp.take_along_axis(s, eidx, axis=-1)
    wts = wts / jnp.sum(wts, -1, keepdims=True) * ROUTED_SCALE
    n_asg = n_tok * TOP_K
    flat_e = eidx.reshape(n_asg)
    order = jnp.argsort(flat_e)
    e_sorted = flat_e[order]
    tok_sorted = (order // TOP_K).astype(jnp.int32)
    w_sorted = wts.reshape(n_asg)[order]
    counts = jnp.bincount(flat_e, length=N_EXPERTS)
    starts = jnp.cumsum(counts) - counts
    padded = (counts + MOE_BLOCK - 1) // MOE_BLOCK * MOE_BLOCK
    pstarts = jnp.cumsum(padded) - padded
    dest = pstarts[e_sorted] + jnp.arange(n_asg) - starts[e_sorted]
    n_blocks = -(-n_asg // MOE_BLOCK) + N_EXPERTS
    row_tok = jnp.zeros((n_blocks * MOE_BLOCK,), jnp.int32).at[dest].set(tok_sorted)
    row_w = jnp.zeros((n_blocks * MOE_BLOCK,), jnp.float32).at[dest].set(w_sorted)
    blk_e = jnp.clip(jnp.searchsorted(pstarts, jnp.arange(n_blocks) * MOE_BLOCK, side='right') - 1,
                     0, N_EXPERTS - 1)

    def expert_block(acc, inp):
        e, toks, w = inp
        xb = xt[toks]
        yb = (jax.nn.silu(xb @ exp_gate[e]) * (xb @ exp_up[e])) @ exp_down[e]
        return acc.at[toks].add(yb.astype(jnp.float32) * w[:, None]), None

    routed, _ = lax.scan(expert_block, jnp.zeros((n_tok, D), jnp.float32),
                         (blk_e, row_tok.reshape(n_blocks, MOE_BLOCK), row_w.reshape(n_blocks, MOE_BLOCK)))
    shared = (jax.nn.silu(xt @ sh_gate) * (xt @ sh_up)) @ sh_down
    return (shared.astype(jnp.float32) + routed).astype(h.dtype).reshape(B, T, D)


def setup_inputs(seed: int = 0) -> dict:
    key = jax.random.key(seed)
    ks = jax.random.split(key, 24)
    L = DEPTH

    def nrm(k, shape, scale):
        return jax.random.normal(k, shape, jnp.float32) * scale

    return {
        'x': nrm(ks[0], (BATCH, SEQ, D_MODEL), 1.0),
        'c': nrm(ks[1], (BATCH, D_MODEL), 1.0),
        'w_ada': nrm(ks[2], (L, D_MODEL, 6 * D_MODEL), 0.5 * D_MODEL ** -0.5),
        'b_ada': nrm(ks[3], (L, 6 * D_MODEL), 0.02),
        'w_in': nrm(ks[4], (L, D_MODEL, IN_COLS), D_MODEL ** -0.5),
        'cmp_pe': nrm(ks[5], (L, 2, CMP_BLOCK, HEAD_DIM), 0.1),
        'cmp_w1': nrm(ks[6], (L, 2, CMP_BLOCK * HEAD_DIM, CMP_HIDDEN), (CMP_BLOCK * HEAD_DIM) ** -0.5),
        'cmp_w2': nrm(ks[7], (L, 2, CMP_HIDDEN, HEAD_DIM), CMP_HIDDEN ** -0.5),
        'pool_w': nrm(ks[8], (L, POOL_GROUPS, POOL_GDIM, POOL_GDIM), POOL_GDIM ** -0.5),
        'pool_scale': 1.0 + nrm(ks[9], (L, GROUP_WIDTH), 0.1),
        'gla_wa': nrm(ks[10], (L, GLA_LOWRANK, GROUP_WIDTH), GLA_LOWRANK ** -0.5),
        'gla_ba': nrm(ks[11], (L, GROUP_WIDTH), 0.1),
        'gla_norm': 1.0 + nrm(ks[12], (L, HEAD_DIM), 0.1),
        'w_out': nrm(ks[13], (L, D_MIX, D_MODEL), D_MIX ** -0.5 * DEEPNORM_BETA),
        'ln_g': 1.0 + nrm(ks[14], (L, 2, D_MODEL), 0.1),
        'ln_b': nrm(ks[15], (L, 2, D_MODEL), 0.02),
        'w_router': nrm(ks[16], (L, D_MODEL, N_EXPERTS), D_MODEL ** -0.5),
        'router_bias': nrm(ks[17], (L, N_EXPERTS), 0.01),
        'exp_gate': nrm(ks[18], (L, N_EXPERTS, D_MODEL, D_EXPERT), D_MODEL ** -0.5),
        'exp_up': nrm(ks[19], (L, N_EXPERTS, D_MODEL, D_EXPERT), D_MODEL ** -0.5),
        'exp_down': nrm(ks[20], (L, N_EXPERTS, D_EXPERT, D_MODEL), D_EXPERT ** -0.5 * DEEPNORM_BETA),
        'sh_gate': nrm(ks[21], (L, D_MODEL, D_SHARED), D_MODEL ** -0.5),
        'sh_up': nrm(ks[22], (L, D_MODEL, D_SHARED), D_MODEL ** -0.5),
        'sh_down': nrm(ks[23], (L, D_SHARED, D_MODEL), D_SHARED ** -0.5 * DEEPNORM_BETA),
    }


def reference(x, c, w_ada, b_ada, w_in, cmp_pe, cmp_w1, cmp_w2, pool_w, pool_scale, gla_wa, gla_ba, gla_norm,
              w_out, ln_g, ln_b, w_router, router_bias, exp_gate, exp_up, exp_down, sh_gate, sh_up, sh_down):
    for l in range(DEPTH):
        mod = jax.nn.silu(c) @ w_ada[l] + b_ada[l]
        sh_m, sc_m, g_m, sh_f, sc_f, g_f = [m[:, None, :] for m in jnp.split(mod, 6, axis=-1)]
        h = x * (1.0 + sc_m) + sh_m
        y = token_mixers(h, w_in[l], cmp_pe[l], cmp_w1[l], cmp_w2[l], pool_w[l], pool_scale[l],
                         gla_wa[l], gla_ba[l], gla_norm[l], w_out[l])
        x = layer_norm(DEEPNORM_ALPHA * x + g_m * y, ln_g[l, 0], ln_b[l, 0])
        h = x * (1.0 + sc_f) + sh_f
        y = moe_ffn(h, w_router[l], router_bias[l], exp_gate[l], exp_up[l], exp_down[l],
                    sh_gate[l], sh_up[l], sh_down[l])
        x = layer_norm(DEEPNORM_ALPHA * x + g_f * y, ln_g[l, 1], ln_b[l, 1])
    return x
```

```cpp
#include <hip/hip_runtime.h>
#include <stdint.h>
#include <stdio.h>

typedef unsigned short bf16_t;
typedef short bf16x8 __attribute__((ext_vector_type(8)));
typedef float f32x4 __attribute__((ext_vector_type(4)));
typedef __bf16 bf16x2_t __attribute__((ext_vector_type(2)));
typedef float f32x2_t __attribute__((ext_vector_type(2)));

#define XB_TMO      128
#define XB_XCNT(j)  (256  + 64 * (j))
#define XB_XSUB(j)  (1280 + 64 * (j))
#define XB_XGEN(j)  (2304 + 64 * (j))
#define XB_TOP      3328
#define XB_TOPGEN   3392
#define XCD_BAR_WORDS 3456
#define XB_SPIN_CAP (1u << 18)
#define LAS __attribute__((address_space(3)))

__device__ __forceinline__ unsigned xb_ld(unsigned* p)              { return __hip_atomic_load(p, __ATOMIC_RELAXED, __HIP_MEMORY_SCOPE_AGENT); }
__device__ __forceinline__ unsigned xb_add(unsigned* p, unsigned v) { return __hip_atomic_fetch_add(p, v, __ATOMIC_RELAXED, __HIP_MEMORY_SCOPE_AGENT); }
__device__ __forceinline__ unsigned xb_xcc_id() { return (unsigned)__builtin_amdgcn_s_getreg((3 << 11) | 20) & 0xFu; }
#define XB_SPIN(cond, bar) do { unsigned _sp = 0; while (cond) { __builtin_amdgcn_s_sleep(1); \
    if ((++_sp & 255u) == 0u) { if (xb_ld(&(bar)[XB_TMO])) break; if (_sp > XB_SPIN_CAP) { atomicAdd(&(bar)[XB_TMO], 1u); break; } } } } while (0)

struct XcdBarrier { unsigned* bar; unsigned x; volatile LAS unsigned* st; };

__device__ __forceinline__ XcdBarrier xcd_barrier_post(unsigned* bar, volatile LAS unsigned* st) {
    XcdBarrier b; b.bar = bar; b.x = xb_xcc_id(); b.st = st;
    if (threadIdx.x == 0) (void)xb_add(&bar[XB_XCNT(b.x)], 1u);
    return b;
}
__device__ __forceinline__ void xcd_barrier_complete(unsigned* bar, unsigned x, unsigned& nloc, unsigned& nx) {
    const unsigned G = gridDim.x * gridDim.y * gridDim.z;
    unsigned sum, cnt, mine, sp = 0u;
    for (;;) {
        sum = 0u; cnt = 0u; mine = 0u;
#pragma unroll
        for (unsigned j = 0; j < 16; ++j) { const unsigned c = xb_ld(&bar[XB_XCNT(j)]); sum += c; cnt += (c > 0u) ? 1u : 0u; mine = (j == x) ? c : mine; }
        if (sum == G) break;
        __builtin_amdgcn_s_sleep(1);
        if ((++sp & 255u) == 0u) { if (xb_ld(&bar[XB_TMO])) break; if (sp > XB_SPIN_CAP) { atomicAdd(&bar[XB_TMO], 1u); break; } }
    }
    nloc = mine > 0u ? mine : 1u; nx = cnt > 0u ? cnt : 1u;
}
__device__ __forceinline__ void xcd_barrier(const XcdBarrier& b) {
    asm volatile("s_waitcnt vmcnt(0)" ::: "memory");
    __syncthreads();
    if (threadIdx.x == 0) {
        unsigned* bar = b.bar;
        __builtin_amdgcn_s_waitcnt(0);
        unsigned nloc = b.st[0], nx = b.st[1];
        if (nloc == 0u) { xcd_barrier_complete(bar, b.x, nloc, nx); b.st[0] = nloc; b.st[1] = nx; }
        const unsigned old = xb_add(&bar[XB_XSUB(b.x)], 1u);
        const unsigned gen = old / nloc;
        if (old + 1u == (gen + 1u) * nloc) {
            __builtin_amdgcn_fence(__ATOMIC_RELEASE, "agent");
            asm volatile("s_waitcnt vmcnt(0)" ::: "memory");
            const unsigned og = xb_add(&bar[XB_TOP], 1u);
            const unsigned tg = og / nx;
            if (og + 1u == (tg + 1u) * nx) xb_add(&bar[XB_TOPGEN], 1u);
            else XB_SPIN(xb_ld(&bar[XB_TOPGEN]) == tg, bar);
            __builtin_amdgcn_fence(__ATOMIC_ACQUIRE, "agent");
            xb_add(&bar[XB_XGEN(b.x)], 1u);
            asm volatile("s_waitcnt vmcnt(0)" ::: "memory");
        } else {
            XB_SPIN(xb_ld(&bar[XB_XGEN(b.x)]) == gen, bar);
            __builtin_amdgcn_fence(__ATOMIC_ACQUIRE, "agent");
            asm volatile("s_waitcnt vmcnt(0)" ::: "memory");
        }
    }
    __syncthreads();
}

#define SEQ 8192
#define NTOK 16384
#define DM 1024
#define NLAYER 2
#define INCOLS 2716
#define ZLD 2720
#define Z_MQ 0
#define Z_MK 256
#define Z_NQ 768
#define Z_KC 1024
#define Z_VC 1088
#define Z_KS 1152
#define Z_KW 1280
#define Z_GATE 1408
#define Z_POOL 1424
#define Z_GQ 1680
#define Z_GK 1936
#define Z_GV 2192
#define Z_GA 2448
#define Z_GG 2464
#define NEXP 256
#define ALPHA 1.41421356237f
#define LN_EPS 1e-5f

#define WS_BAR   0ull
#define WS_QCTR  16384ull
#define WS_CNT   32768ull
#define CSTR     32
#define WS_ZERO_BYTES 163840ull
#define WS_ROPE  163840ull
#define WS_MOD   (WS_ROPE + 8192ull * 8 * 8)
#define WS_PBIAS 802816ull
#define WS_XA    (1ull << 20)
#define WS_XB    (WS_XA + 67108864ull)
#define WS_H     (WS_XB + 67108864ull)
#define WS_Z     (WS_H + 33554432ull)
#define WS_QROT  (WS_Z + 16384ull * ZLD * 2)
#define WS_VTM   (WS_QROT + 16384ull * 256 * 2)
#define WS_VTS   (WS_VTM + 2ull * 4 * 64 * 8192 * 2)
#define WS_VTW   (WS_VTS + 2ull * 64 * 8192 * 2)
#define WS_KMEAN (WS_VTW + 2ull * 64 * 8192 * 2)
#define WS_KC    (WS_KMEAN + 2ull * 4 * 32 * 64 * 4)
#define WS_VCT   (WS_KC + 2ull * 512 * 64 * 2)
#define WS_BCUM  (WS_VCT + 2ull * 512 * 64 * 2)
#define WS_U     (WS_BCUM + 16384ull * 256 * 4)
#define WS_AEND  (WS_U + 2ull * 4 * 128 * 4096 * 4)
#define WS_OCAT  (WS_AEND + 2ull * 4 * 128 * 64 * 4)
#define WS_R1    (WS_OCAT + 33554432ull)
#define WS_LOGIT (WS_R1 + 67108864ull)
#define WS_EW    (WS_LOGIT + 16384ull * 256 * 4)
#define WS_LIST  (WS_EW + 16384ull * 8 * 4)
#define WS_HID   (WS_LIST + 256ull * 16384 * 4)
#define WS_SLOT  (WS_HID + (131072ull + 16384) * 256 * 2)
#define WS_YSH   (WS_SLOT + 16384ull * 8 * 1024 * 2)
#define WS_CPART (WS_YSH + 33554432ull)
#define WS_WT    (WS_CPART + 8ull * 2 * 1024 * 128 * 4)
#define WT_IN    0ull
#define WT_OUT   (2816ull * 1024)
#define WT_R     (WT_OUT + 1024ull * 1024)
#define WT_SGU   (WT_R + 256ull * 1024)
#define WT_SD    (WT_SGU + 512ull * 1024)
#define WT_W1    (WT_SD + 1024ull * 256)
#define WT_LAYER (WT_W1 + 2ull * 128 * 2048)
#define WS_END   (WS_WT + 2ull * WT_LAYER * 2)

#define SMEM_BYTES 73728

#define rope  ((float2*)(ws + WS_ROPE))
#define modb  ((float*)(ws + WS_MOD))
#define xA    ((float*)(ws + WS_XA))
#define xB    ((float*)(ws + WS_XB))
#define hbuf  ((bf16_t*)(ws + WS_H))
#define zb    ((bf16_t*)(ws + WS_Z))
#define qrot  ((bf16_t*)(ws + WS_QROT))
#define vtm   ((bf16_t*)(ws + WS_VTM))
#define vts   ((bf16_t*)(ws + WS_VTS))
#define vtw   ((bf16_t*)(ws + WS_VTW))
#define kmean ((float*)(ws + WS_KMEAN))
#define kcb   ((bf16_t*)(ws + WS_KC))
#define vct   ((bf16_t*)(ws + WS_VCT))
#define bcum  ((float*)(ws + WS_BCUM))
#define Ub    ((float*)(ws + WS_U))
#define aend  ((float*)(ws + WS_AEND))
#define ocat  ((bf16_t*)(ws + WS_OCAT))
#define r1    ((float*)(ws + WS_R1))
#define r1h   ((bf16_t*)(ws + WS_R1))
#define xAh   ((bf16_t*)(ws + WS_XA))
#define xBh   ((bf16_t*)(ws + WS_XB))
#define logit ((float*)(ws + WS_LOGIT))
#define ewb   ((float*)(ws + WS_EW))
#define listb ((int*)(ws + WS_LIST))
#define hid   ((bf16_t*)(ws + WS_HID))
#define slot  ((bf16_t*)(ws + WS_SLOT))
#define slot8 ((unsigned char*)(ws + WS_SLOT))
#define sscl  ((unsigned char*)(ws + WS_SLOT + 134217728ull))
#define ysh   ((bf16_t*)(ws + WS_YSH))
#define cntb  ((unsigned*)(ws + WS_CNT))
#define cpart ((float*)(ws + WS_CPART))
#define pbias ((float*)(ws + WS_PBIAS))
#define WTL(L_) ((bf16_t*)(ws + WS_WT) + (size_t)(L_) * WT_LAYER)
#define QCTR(L_, i_) ((unsigned*)(ws + WS_QCTR + ((size_t)(L_) * 16 + (i_)) * 256))

struct Params {
    const float *x, *c, *w_ada, *b_ada, *w_in, *cmp_pe, *cmp_w1, *cmp_w2, *pool_w, *pool_scale, *gla_wa, *gla_ba, *gla_norm,
                *w_out, *ln_g, *ln_b, *w_router, *router_bias, *exp_gate, *exp_up, *exp_down, *sh_gate, *sh_up, *sh_down;
    float* out; unsigned char* ws;
};

__device__ __forceinline__ unsigned pack2(float lo, float hi) { f32x2_t v = {lo, hi}; bf16x2_t b = __builtin_convertvector(v, bf16x2_t); return *(unsigned*)&b; }
__device__ __forceinline__ float bflo(unsigned u) { return __uint_as_float(u << 16); }
__device__ __forceinline__ float bfhi(unsigned u) { return __uint_as_float(u & 0xffff0000u); }
__device__ __forceinline__ float bf2f(bf16_t h) { return __uint_as_float(((unsigned)h) << 16); }
__device__ __forceinline__ bf16_t f2bf(float f) { return (bf16_t)(pack2(f, 0.f) & 0xffffu); }
__device__ __forceinline__ int swz(int row, int chunk) { return row * 128 + (((chunk ^ ((row >> 2) ^ row)) & 7) << 4); }
__device__ __forceinline__ void glds16(const bf16_t* gp, unsigned char* lp) { __builtin_amdgcn_global_load_lds((const unsigned*)gp, (unsigned*)lp, 16, 0, 0); }
__device__ __forceinline__ float sigmoidf_(float x) { return __builtin_amdgcn_rcpf(1.f + __expf(-x)); }
__device__ __forceinline__ float siluf_(float x) { return x * __builtin_amdgcn_rcpf(1.f + __expf(-x)); }
#define NEG_INF (-__builtin_huge_valf())
__device__ __forceinline__ float xr_max(float v) {
    unsigned u = __float_as_uint(v); auto r = __builtin_amdgcn_permlane16_swap(u, u, false, false);
    v = __builtin_elementwise_maximum(__uint_as_float(r[0]), __uint_as_float(r[1]));
    u = __float_as_uint(v); auto r2 = __builtin_amdgcn_permlane32_swap(u, u, false, false);
    return __builtin_elementwise_maximum(__uint_as_float(r2[0]), __uint_as_float(r2[1]));
}
__device__ __forceinline__ float xr_sum(float v) {
    unsigned u = __float_as_uint(v); auto r = __builtin_amdgcn_permlane16_swap(u, u, false, false);
    v = __uint_as_float(r[0]) + __uint_as_float(r[1]);
    u = __float_as_uint(v); auto r2 = __builtin_amdgcn_permlane32_swap(u, u, false, false);
    return __uint_as_float(r2[0]) + __uint_as_float(r2[1]);
}
#define EXP2(x) __builtin_amdgcn_exp2f(x)
typedef unsigned long long u64_t;
template <int CTRL> __device__ __forceinline__ float dppf(float v) { return __uint_as_float(__builtin_amdgcn_update_dpp(0u, __float_as_uint(v), CTRL, 0xf, 0xf, true)); }
template <int CTRL> __device__ __forceinline__ u64_t dpp64(u64_t v) {
    const unsigned lo = __builtin_amdgcn_update_dpp(0u, (unsigned)v, CTRL, 0xf, 0xf, true), hi = __builtin_amdgcn_update_dpp(0u, (unsigned)(v >> 32), CTRL, 0xf, 0xf, true);
    return ((u64_t)hi << 32) | lo; }
__device__ __forceinline__ float wave_sum(float v) {
    v += dppf<0xB1>(v); v += dppf<0x4E>(v); v += dppf<0x141>(v); v += dppf<0x140>(v);
    return xr_sum(v);
}
__device__ __forceinline__ u64_t max64(u64_t a, u64_t b) { return a > b ? a : b; }
__device__ __forceinline__ u64_t wave_max64(u64_t v) {
    v = max64(v, dpp64<0xB1>(v)); v = max64(v, dpp64<0x4E>(v)); v = max64(v, dpp64<0x141>(v)); v = max64(v, dpp64<0x140>(v));
    { const unsigned lo = (unsigned)v, hi = (unsigned)(v >> 32); auto a = __builtin_amdgcn_permlane16_swap(lo, lo, false, false); auto b = __builtin_amdgcn_permlane16_swap(hi, hi, false, false);
      v = max64(((u64_t)b[0] << 32) | a[0], ((u64_t)b[1] << 32) | a[1]); }
    { const unsigned lo = (unsigned)v, hi = (unsigned)(v >> 32); auto a = __builtin_amdgcn_permlane32_swap(lo, lo, false, false); auto b = __builtin_amdgcn_permlane32_swap(hi, hi, false, false);
      v = max64(((u64_t)b[0] << 32) | a[0], ((u64_t)b[1] << 32) | a[1]); }
    return v;
}


template <int BM, int WM, class AOF, class BOF, class EPF>
__device__ __forceinline__ void gemm_dma(unsigned char* smem, const int t, int nkt, const bf16_t* abase, AOF arow, long akstride, const bf16_t* bbase, BOF brow, EPF epi) {
    constexpr int WN = 4 / WM, MI = BM / (16 * WM), NI = 128 / (16 * WN), AJ = BM / 32;
    const int lane = t & 63, wid = __builtin_amdgcn_readfirstlane(t >> 6), wr = wid / WN, wc = wid % WN, fr = lane & 15, g = lane >> 4;
    unsigned ao[AJ], bo[4];
#pragma unroll
    for (int j = 0; j < AJ; ++j) { const int row = 8 * (wid * AJ + j) + (lane >> 3); const int c = ((lane & 7) ^ ((row >> 2) ^ row)) & 7; ao[j] = arow(row) + (unsigned)(c * 8); }
#pragma unroll
    for (int j = 0; j < 4; ++j) { const int row = 8 * (wid * 4 + j) + (lane >> 3); const int c = ((lane & 7) ^ ((row >> 2) ^ row)) & 7; bo[j] = brow(row) + (unsigned)(c * 8); }
    f32x4 acc[MI][NI];
#pragma unroll
    for (int m = 0; m < MI; ++m)
#pragma unroll
        for (int n = 0; n < NI; ++n) acc[m][n] = (f32x4){0.f, 0.f, 0.f, 0.f};
    auto issue = [&](int kt) {
        unsigned char* sA = smem + (kt & 1) * 32768; unsigned char* sB = sA + 16384;
        const bf16_t* ab = abase + (long)kt * akstride; const bf16_t* bb = bbase + kt * 64;
#pragma unroll
        for (int j = 0; j < AJ; ++j) glds16(ab + ao[j], sA + (wid * AJ + j) * 1024);
#pragma unroll
        for (int j = 0; j < 4; ++j) glds16(bb + bo[j], sB + (wid * 4 + j) * 1024);
    };
    issue(0);
    for (int kt = 0; kt < nkt; ++kt) {
        asm volatile("s_waitcnt vmcnt(0)" ::: "memory");
        __syncthreads();
        if (kt + 1 < nkt) issue(kt + 1);
        const unsigned char* sA = smem + (kt & 1) * 32768; const unsigned char* sB = sA + 16384;
#pragma unroll
        for (int ks = 0; ks < 2; ++ks) {
            bf16x8 a[MI], b[NI];
#pragma unroll
            for (int m = 0; m < MI; ++m) a[m] = *(const bf16x8*)(sA + swz(wr * (BM / WM) + m * 16 + fr, ks * 4 + g));
#pragma unroll
            for (int n = 0; n < NI; ++n) b[n] = *(const bf16x8*)(sB + swz(wc * (128 / WN) + n * 16 + fr, ks * 4 + g));
#pragma unroll
            for (int m = 0; m < MI; ++m)
#pragma unroll
                for (int n = 0; n < NI; ++n) acc[m][n] = __builtin_amdgcn_mfma_f32_16x16x32_bf16(b[n], a[m], acc[m][n], 0, 0, 0);
        }
    }
    __syncthreads();
    epi(acc, wr, wc, fr, g);
}

template <int WM, class AOF, class EPF>
__device__ __forceinline__ void gemm_fb(unsigned char* smem, const int t, int NT, int nkt, const bf16_t* abase, AOF arow, const float* b0, const float* b1, long bstep, long ldb, EPF epi) {
    constexpr int WN = 4 / WM, MI = 128 / (16 * WM), NI = 128 / (16 * WN);
    const int lane = t & 63, wid = __builtin_amdgcn_readfirstlane(t >> 6), wr = wid / WN, wc = wid % WN, fr = lane & 15, g = lane >> 4;
    unsigned ao[4];
#pragma unroll
    for (int j = 0; j < 4; ++j) { const int row = 8 * (wid * 4 + j) + (lane >> 3); const int c = ((lane & 7) ^ ((row >> 2) ^ row)) & 7; ao[j] = arow(row) + (unsigned)(c * 8); }
    const int ng = (t & 7) + 8 * ((t >> 4) & 1), kg = ((t >> 3) & 1) + 2 * (t >> 5);
    const unsigned boff = (unsigned)(kg * 4) * (unsigned)ldb + (unsigned)(ng * 4);
    const int prow = ((((ng >> 3) & 1) * 2 + (ng & 1)) * 16) + 4 * ((ng >> 1) & 3);
    float4 bq[2][4];
    f32x4 acc[MI][NI];
#pragma unroll
    for (int m = 0; m < MI; ++m)
#pragma unroll
        for (int n = 0; n < NI; ++n) acc[m][n] = (f32x4){0.f, 0.f, 0.f, 0.f};
    const int nsteps = NT * nkt;
    auto issueA = [&](int s) {
        const int kt = s % nkt;
        unsigned char* sA = smem + (s & 1) * 16384;
        const bf16_t* ab = abase + kt * 64;
#pragma unroll
        for (int j = 0; j < 4; ++j) glds16(ab + ao[j], sA + (wid * 4 + j) * 1024);
    };
    auto loadB = [&](int s) {
        const int nt = s / nkt, kt = s % nkt;
        const float* p0 = b0 + (long)nt * bstep + (long)kt * 64 * ldb + boff; const float* p1 = b1 + (long)nt * bstep + (long)kt * 64 * ldb + boff;
#pragma unroll
        for (int i = 0; i < 4; ++i) { bq[0][i] = *(const float4*)(p0 + (long)i * ldb); bq[1][i] = *(const float4*)(p1 + (long)i * ldb); }
    };
    auto storeB = [&](int s) {
        unsigned char* sB = smem + 32768 + (s & 1) * 16384;
#pragma unroll
        for (int pp = 0; pp < 2; ++pp) {
            const float q0[4] = {bq[pp][0].x, bq[pp][0].y, bq[pp][0].z, bq[pp][0].w}, q1[4] = {bq[pp][1].x, bq[pp][1].y, bq[pp][1].z, bq[pp][1].w};
            const float q2[4] = {bq[pp][2].x, bq[pp][2].y, bq[pp][2].z, bq[pp][2].w}, q3[4] = {bq[pp][3].x, bq[pp][3].y, bq[pp][3].z, bq[pp][3].w};
#pragma unroll
            for (int i = 0; i < 4; ++i) { uint2 w; w.x = pack2(q0[i], q1[i]); w.y = pack2(q2[i], q3[i]);
                *(uint2*)(sB + swz(pp * 64 + prow + i, kg >> 1) + (kg & 1) * 8) = w; }
        }
    };
    issueA(0); loadB(0);
    asm volatile("s_waitcnt vmcnt(0)" ::: "memory");
    storeB(0);
    if (nsteps > 1) loadB(1);
    for (int s = 0; s < nsteps; ++s) {
        asm volatile("s_waitcnt vmcnt(0)" ::: "memory");
        __syncthreads();
        if (s + 1 < nsteps) { storeB(s + 1); issueA(s + 1); if (s + 2 < nsteps) loadB(s + 2); }
        const unsigned char* sA = smem + (s & 1) * 16384; const unsigned char* sB = smem + 32768 + (s & 1) * 16384;
#pragma unroll
        for (int ks = 0; ks < 2; ++ks) {
            bf16x8 a[MI], b[NI];
#pragma unroll
            for (int m = 0; m < MI; ++m) a[m] = *(const bf16x8*)(sA + swz(wr * (128 / WM) + m * 16 + fr, ks * 4 + g));
#pragma unroll
            for (int n = 0; n < NI; ++n) b[n] = *(const bf16x8*)(sB + swz(wc * (128 / WN) + n * 16 + fr, ks * 4 + g));
#pragma unroll
            for (int m = 0; m < MI; ++m)
#pragma unroll
                for (int n = 0; n < NI; ++n) acc[m][n] = __builtin_amdgcn_mfma_f32_16x16x32_bf16(b[n], a[m], acc[m][n], 0, 0, 0);
        }
        if ((s + 1) % nkt == 0) {
            epi(acc, s / nkt, wr, wc, fr, g);
#pragma unroll
            for (int m = 0; m < MI; ++m)
#pragma unroll
                for (int n = 0; n < NI; ++n) acc[m][n] = (f32x4){0.f, 0.f, 0.f, 0.f};
        }
    }
    __syncthreads();
}

template <class AOF, class EPF>
__device__ __forceinline__ void gemm_fbr(unsigned char* smem, const int t, int NT, const bf16_t* abase, AOF arow, const float* b0, const float* b1, long bstep, long ldb, EPF epi) {
    const int lane = t & 63, wid = __builtin_amdgcn_readfirstlane(t >> 6), fr = lane & 15, g = lane >> 4;
    bf16x8 afr[2][8];
#pragma unroll
    for (int m = 0; m < 2; ++m) { const bf16_t* ap = abase + arow(wid * 32 + m * 16 + fr) + g * 8;
#pragma unroll
        for (int ks = 0; ks < 8; ++ks) afr[m][ks] = *(const bf16x8*)(ap + ks * 32); }
    const int ng = (t & 7) + 8 * ((t >> 4) & 1), kg = ((t >> 3) & 1) + 2 * (t >> 5);
    const unsigned boff = (unsigned)(kg * 4) * (unsigned)ldb + (unsigned)(ng * 4);
    const int prow = ((((ng >> 3) & 1) * 2 + (ng & 1)) * 16) + 4 * ((ng >> 1) & 3);
    float4 bq[2][4];
    f32x4 acc[2][8];
#pragma unroll
    for (int m = 0; m < 2; ++m)
#pragma unroll
        for (int n = 0; n < 8; ++n) acc[m][n] = (f32x4){0.f, 0.f, 0.f, 0.f};
    const int nsteps = NT * 4;
    auto loadB = [&](int s) {
        const int nt = s >> 2, kt = s & 3;
        const float* p0 = b0 + (long)nt * bstep + (long)kt * 64 * ldb + boff; const float* p1 = b1 + (long)nt * bstep + (long)kt * 64 * ldb + boff;
#pragma unroll
        for (int i = 0; i < 4; ++i) { bq[0][i] = *(const float4*)(p0 + (long)i * ldb); bq[1][i] = *(const float4*)(p1 + (long)i * ldb); }
    };
    auto storeB = [&](int s) {
        unsigned char* sB = smem + (s & 1) * 16384;
#pragma unroll
        for (int pp = 0; pp < 2; ++pp) {
            const float q0[4] = {bq[pp][0].x, bq[pp][0].y, bq[pp][0].z, bq[pp][0].w}, q1[4] = {bq[pp][1].x, bq[pp][1].y, bq[pp][1].z, bq[pp][1].w};
            const float q2[4] = {bq[pp][2].x, bq[pp][2].y, bq[pp][2].z, bq[pp][2].w}, q3[4] = {bq[pp][3].x, bq[pp][3].y, bq[pp][3].z, bq[pp][3].w};
#pragma unroll
            for (int i = 0; i < 4; ++i) { uint2 w; w.x = pack2(q0[i], q1[i]); w.y = pack2(q2[i], q3[i]);
                *(uint2*)(sB + swz(pp * 64 + prow + i, kg >> 1) + (kg & 1) * 8) = w; }
        }
    };
    loadB(0);
    storeB(0);
    loadB(1);
    for (int nt = 0; nt < NT; ++nt) {
#pragma unroll
        for (int kt = 0; kt < 4; ++kt) {
            const int s = nt * 4 + kt;
            __syncthreads();
            if (s + 1 < nsteps) { storeB(s + 1); if (s + 2 < nsteps) loadB(s + 2); }
            const unsigned char* sB = smem + (kt & 1) * 16384;
#pragma unroll
            for (int ks = 0; ks < 2; ++ks) {
#pragma unroll
                for (int nh2 = 0; nh2 < 2; ++nh2) {
                    bf16x8 b[4];
#pragma unroll
                    for (int n = 0; n < 4; ++n) b[n] = *(const bf16x8*)(sB + swz((nh2 * 4 + n) * 16 + fr, ks * 4 + g));
#pragma unroll
                    for (int m = 0; m < 2; ++m)
#pragma unroll
                        for (int n = 0; n < 4; ++n) acc[m][nh2 * 4 + n] = __builtin_amdgcn_mfma_f32_16x16x32_bf16(b[n], afr[m][2 * kt + ks], acc[m][nh2 * 4 + n], 0, 0, 0);
                    __builtin_amdgcn_sched_barrier(0);
                }
            }
        }
        epi(acc, nt, wid, fr, g);
#pragma unroll
        for (int m = 0; m < 2; ++m)
#pragma unroll
            for (int n = 0; n < 8; ++n) acc[m][n] = (f32x4){0.f, 0.f, 0.f, 0.f};
    }
    __syncthreads();
}

__device__ __forceinline__ int swz32(int row, int chunk) { return row * 64 + (((chunk ^ (0 - (row >> 2))) & 3) << 4); }
__device__ __forceinline__ void glds16_asm(const void* g, unsigned lds_base) {
    unsigned sv; asm volatile("s_mov_b32 %0, m0\n\ts_mov_b32 m0, %2\n\ts_nop 0\n\tglobal_load_lds_dwordx4 %1, off\n\ts_mov_b32 m0, %0" : "=&s"(sv) : "v"(g), "s"(lds_base) : "memory"); }
template <class AOF, class EPF>
__device__ __forceinline__ void gemm_fb256(unsigned char* smem, const int t, int nk, const bf16_t* abase, AOF arow, const float* b0, const float* b1, long ldb, EPF epi) {
    const int lane = t & 63, wid = __builtin_amdgcn_readfirstlane(t >> 6), fr = lane & 15, g = lane >> 4;
    const unsigned lds0 = (unsigned)(uintptr_t)smem;
    unsigned ao[4];
#pragma unroll
    for (int j = 0; j < 4; ++j) { const int row = 16 * (wid * 4 + j) + (lane >> 2); const int c = ((lane & 3) ^ (0 - (row >> 2))) & 3; ao[j] = arow(row) + (unsigned)(c * 8); }
    const int ng = t & 15, kg = (t >> 4) & 7, pp = t >> 7;
    const float* bsrc = (pp ? b1 : b0) + (long)(kg * 4) * ldb + ng * 4;
    const int prow = pp * 64 + ((((ng >> 3) & 1) * 2 + (ng & 1)) * 16) + 4 * ((ng >> 1) & 3);
    f32x4 bqa[4], bqb[4];
    f32x4 acc[4][8];
#pragma unroll
    for (int m = 0; m < 4; ++m)
#pragma unroll
        for (int n = 0; n < 8; ++n) acc[m][n] = (f32x4){0.f, 0.f, 0.f, 0.f};
    auto issueA = [&](int s, int sbuf) {
        const unsigned sA = lds0 + (sbuf & 1) * 16384 + wid * 4096;
        const bf16_t* ab = abase + s * 32;
#pragma unroll
        for (int j = 0; j < 4; ++j) glds16_asm(ab + ao[j], sA + j * 1024);
    };
#define FB_LOADB(S_, BQ_) { const float* p0_ = bsrc + (long)(S_) * 32 * 256; \
        asm volatile("global_load_dwordx4 %0, %4, off\n\tglobal_load_dwordx4 %1, %4, off offset:1024\n\tglobal_load_dwordx4 %2, %4, off offset:2048\n\tglobal_load_dwordx4 %3, %4, off offset:3072" \
                     : "=&v"(BQ_[0]), "=&v"(BQ_[1]), "=&v"(BQ_[2]), "=&v"(BQ_[3]) : "v"(p0_) : "memory"); }
#define FB_WAIT(N_, BQ_) asm volatile("s_waitcnt vmcnt(" #N_ ")" : "+v"(BQ_[0]), "+v"(BQ_[1]), "+v"(BQ_[2]), "+v"(BQ_[3]) :: "memory")
#define FB_STOREB(S_, BQ_) { unsigned char* sB_ = smem + 32768 + ((S_) & 1) * 8192; \
        { uint2 w_; w_.x = pack2(BQ_[0][0], BQ_[1][0]); w_.y = pack2(BQ_[2][0], BQ_[3][0]); *(uint2*)(sB_ + swz32(prow + 0, kg >> 1) + (kg & 1) * 8) = w_; } \
        { uint2 w_; w_.x = pack2(BQ_[0][1], BQ_[1][1]); w_.y = pack2(BQ_[2][1], BQ_[3][1]); *(uint2*)(sB_ + swz32(prow + 1, kg >> 1) + (kg & 1) * 8) = w_; } \
        { uint2 w_; w_.x = pack2(BQ_[0][2], BQ_[1][2]); w_.y = pack2(BQ_[2][2], BQ_[3][2]); *(uint2*)(sB_ + swz32(prow + 2, kg >> 1) + (kg & 1) * 8) = w_; } \
        { uint2 w_; w_.x = pack2(BQ_[0][3], BQ_[1][3]); w_.y = pack2(BQ_[2][3], BQ_[3][3]); *(uint2*)(sB_ + swz32(prow + 3, kg >> 1) + (kg & 1) * 8) = w_; } }
    auto compute = [&](int s) {
        const unsigned char* sA = smem + (s & 1) * 16384; const unsigned char* sB = smem + 32768 + (s & 1) * 8192;
        bf16x8 a[4], b[8];
#pragma unroll
        for (int m = 0; m < 4; ++m) a[m] = *(const bf16x8*)(sA + swz32(wid * 64 + m * 16 + fr, g));
#pragma unroll
        for (int n = 0; n < 8; ++n) b[n] = *(const bf16x8*)(sB + swz32(n * 16 + fr, g));
#pragma unroll
        for (int m = 0; m < 4; ++m)
#pragma unroll
            for (int n = 0; n < 8; ++n) acc[m][n] = __builtin_amdgcn_mfma_f32_16x16x32_bf16(b[n], a[m], acc[m][n], 0, 0, 0);
    };
#define FB_STEP(S_, BQ_) { const int s_ = (S_); \
        FB_WAIT(4, BQ_); \
        __syncthreads(); \
        FB_STOREB(s_ + 1, BQ_) issueA(s_ + 1 < nk ? s_ + 1 : nk - 1, s_ + 1); \
        FB_LOADB((s_ + 3 < nk ? s_ + 3 : nk - 1), BQ_) \
        compute(s_); }
    issueA(0, 0); FB_LOADB(0, bqa) FB_LOADB(1, bqb)
    FB_WAIT(4, bqa);
    FB_STOREB(0, bqa)
    FB_LOADB(2, bqa)
    for (int s = 0; s < nk; s += 2) { FB_STEP(s, bqb) FB_STEP(s + 1, bqa) }
    FB_WAIT(0, bqa); FB_WAIT(0, bqb);
    __syncthreads();
    epi(acc, wid, fr, g);
}
#undef FB_LOADB
#undef FB_WAIT
#undef FB_STOREB
#undef FB_STEP

template <class AOF, class BOF, class EPF>
__device__ __forceinline__ void gemm_dma256(unsigned char* smem, const int t, int nk, const bf16_t* abase, AOF arow, const bf16_t* bbase, BOF brow, EPF epi) {
    const int lane = t & 63, wid = __builtin_amdgcn_readfirstlane(t >> 6), fr = lane & 15, g = lane >> 4;
    unsigned ao[4], bo[2];
#pragma unroll
    for (int j = 0; j < 4; ++j) { const int row = 16 * (wid * 4 + j) + (lane >> 2); const int c = ((lane & 3) ^ (0 - (row >> 2))) & 3; ao[j] = arow(row) + (unsigned)(c * 8); }
#pragma unroll
    for (int j = 0; j < 2; ++j) { const int row = 16 * (wid * 2 + j) + (lane >> 2); const int c = ((lane & 3) ^ (0 - (row >> 2))) & 3; bo[j] = brow(row) + (unsigned)(c * 8); }
    f32x4 acc[4][8];
#pragma unroll
    for (int m = 0; m < 4; ++m)
#pragma unroll
        for (int n = 0; n < 8; ++n) acc[m][n] = (f32x4){0.f, 0.f, 0.f, 0.f};
    auto issue = [&](int s) {
        unsigned char* sA = smem + (s & 1) * 24576; unsigned char* sB = sA + 16384;
        const bf16_t* ab = abase + s * 32; const bf16_t* bb = bbase + s * 32;
#pragma unroll
        for (int j = 0; j < 4; ++j) glds16(ab + ao[j], sA + (wid * 4 + j) * 1024);
#pragma unroll
        for (int j = 0; j < 2; ++j) glds16(bb + bo[j], sB + (wid * 2 + j) * 1024);
    };
    issue(0);
    for (int s = 0; s < nk; ++s) {
        asm volatile("s_waitcnt vmcnt(0)" ::: "memory");
        __syncthreads();
        if (s + 1 < nk) issue(s + 1);
        const unsigned char* sA = smem + (s & 1) * 24576; const unsigned char* sB = sA + 16384;
        bf16x8 a[4], b[8];
#pragma unroll
        for (int m = 0; m < 4; ++m) a[m] = *(const bf16x8*)(sA + swz32(wid * 64 + m * 16 + fr, g));
#pragma unroll
        for (int n = 0; n < 8; ++n) b[n] = *(const bf16x8*)(sB + swz32(n * 16 + fr, g));
#pragma unroll
        for (int m = 0; m < 4; ++m)
#pragma unroll
            for (int n = 0; n < 8; ++n) acc[m][n] = __builtin_amdgcn_mfma_f32_16x16x32_bf16(b[n], a[m], acc[m][n], 0, 0, 0);
    }
    __syncthreads();
    epi(acc, wid, fr, g);
}

__device__ __forceinline__ void conv_block(const float* src, long ldn, int nvalid, bf16_t* dst, long dK, unsigned char* buf, const int t) {
    const int ng = t & 15, kg = t >> 4;
    float q[4][4];
#pragma unroll
    for (int i = 0; i < 4; ++i) {
        float4 v = make_float4(0.f, 0.f, 0.f, 0.f);
        if (ng * 4 < nvalid) v = *(const float4*)(src + (long)(kg * 4 + i) * ldn + ng * 4);
        q[i][0] = v.x; q[i][1] = v.y; q[i][2] = v.z; q[i][3] = v.w;
    }
#pragma unroll
    for (int i = 0; i < 4; ++i) {
        uint2 w; w.x = pack2(q[0][i], q[1][i]); w.y = pack2(q[2][i], q[3][i]);
        *(uint2*)(buf + (ng * 4 + i) * 128 + ((kg ^ ((ng & 7) << 1)) << 3)) = w;
    }
    __syncthreads();
#pragma unroll
    for (int ps = 0; ps < 2; ++ps) {
        const int row = (t >> 3) + 32 * ps, c16 = t & 7;
        const uint4 v = *(const uint4*)(buf + row * 128 + (((2 * c16) ^ (((row >> 2) & 7) << 1)) << 3));
        *(uint4*)(dst + (long)row * dK + c16 * 8) = v;
    }
    __syncthreads();
}

struct AttnState { float m, l; f32x4 o[4]; };
__device__ __forceinline__ void attn_init(AttnState& s) { s.m = NEG_INF; s.l = 0.f;
#pragma unroll
    for (int i = 0; i < 4; ++i) s.o[i] = (f32x4){0.f, 0.f, 0.f, 0.f}; }

#define KEY_OF(ni, g, r) (32 * ((ni) >> 1) + 8 * (g) + 4 * ((ni) & 1) + (r))
struct FragBase { int kb, vb; };
__device__ __forceinline__ FragBase frag_base(int fr, int g) {
    const int rf = 8 * (fr >> 2) + (fr & 3), ke = ((2 * (fr >> 2)) ^ (fr & 3)) & 7, kfr = ((fr >> 2) ^ fr) & 7;
    FragBase f; f.kb = rf * 128 + ((g ^ ke) << 4); f.vb = fr * 128 + ((g ^ kfr) << 4);
    return f;
}
__device__ __forceinline__ void qk_tile(f32x4 (&s)[4], const unsigned char* sK, const bf16x8 (&q)[2], const FragBase& fb) {
#pragma unroll
    for (int ni = 0; ni < 4; ++ni) {
        s[ni] = (f32x4){0.f, 0.f, 0.f, 0.f};
#pragma unroll
        for (int ks = 0; ks < 2; ++ks) {
            const bf16x8 kf = *(const bf16x8*)(sK + (ni >> 1) * 4096 + (ni & 1) * 512 + (fb.kb ^ ((ni & 1) * 80) ^ (ks * 64)));
            s[ni] = __builtin_amdgcn_mfma_f32_16x16x32_bf16(kf, q[ks], s[ni], 0, 0, 0);
        }
    }
}
__device__ __forceinline__ void p_pack(bf16x8 (&pf)[2], const f32x4 (&s)[4]) {
#pragma unroll
    for (int kk = 0; kk < 2; ++kk) {
        union { bf16x8 v; unsigned u[4]; } pu;
        pu.u[0] = pack2(s[2 * kk][0], s[2 * kk][1]); pu.u[1] = pack2(s[2 * kk][2], s[2 * kk][3]);
        pu.u[2] = pack2(s[2 * kk + 1][0], s[2 * kk + 1][1]); pu.u[3] = pack2(s[2 * kk + 1][2], s[2 * kk + 1][3]);
        pf[kk] = pu.v;
    }
}
__device__ __forceinline__ void pv_tile(f32x4 (&o)[4], const unsigned char* sV, const bf16x8 (&pf)[2], const FragBase& fb) {
    bf16x8 vf[2][4];
#pragma unroll
    for (int kk = 0; kk < 2; ++kk)
#pragma unroll
        for (int mi = 0; mi < 4; ++mi) vf[kk][mi] = *(const bf16x8*)(sV + mi * 2048 + (fb.vb ^ (((kk ^ mi) & 1) << 6)));
#pragma unroll
    for (int kk = 0; kk < 2; ++kk)
#pragma unroll
        for (int mi = 0; mi < 4; ++mi) o[mi] = __builtin_amdgcn_mfma_f32_16x16x32_bf16(vf[kk][mi], pf[kk], o[mi], 0, 0, 0);
}
#define MAXM(a_, b_) __builtin_elementwise_maximum((a_), (b_))
__device__ __forceinline__ float max16m(const f32x4 (&s)[4]) {
    float a = MAXM(MAXM(s[0][0], s[0][1]), s[0][2]), b = MAXM(MAXM(s[2][0], s[2][1]), s[2][2]);
    a = MAXM(MAXM(a, s[0][3]), s[1][0]); b = MAXM(MAXM(b, s[2][3]), s[3][0]);
    a = MAXM(MAXM(a, s[1][1]), s[1][2]); b = MAXM(MAXM(b, s[3][1]), s[3][2]);
    return MAXM(MAXM(a, b), MAXM(s[1][3], s[3][3]));
}
#define RESCALE_THR 8.f
__device__ __forceinline__ void qk_tile_c(f32x4 (&s)[4], const unsigned char* sK, const bf16x8 (&q)[2], const FragBase& fb, const f32x4 cinit) {
#pragma unroll
    for (int ni = 0; ni < 4; ++ni) {
        s[ni] = cinit;
#pragma unroll
        for (int ks = 0; ks < 2; ++ks) {
            const bf16x8 kf = *(const bf16x8*)(sK + (ni >> 1) * 4096 + (ni & 1) * 512 + (fb.kb ^ ((ni & 1) * 80) ^ (ks * 64)));
            s[ni] = __builtin_amdgcn_mfma_f32_16x16x32_bf16(kf, q[ks], s[ni], 0, 0, 0);
        }
    }
}
__device__ __forceinline__ float max16v(const f32x4 (&s)[4]) {
    float a = fmaxf(fmaxf(s[0][0], s[0][1]), s[0][2]), b = fmaxf(fmaxf(s[2][0], s[2][1]), s[2][2]);
    a = fmaxf(fmaxf(a, s[0][3]), s[1][0]); b = fmaxf(fmaxf(b, s[2][3]), s[3][0]);
    a = fmaxf(fmaxf(a, s[1][1]), s[1][2]); b = fmaxf(fmaxf(b, s[3][1]), s[3][2]);
    return fmaxf(fmaxf(a, b), fmaxf(s[1][3], s[3][3]));
}
template <class MF>
__device__ __forceinline__ void attn_tile(AttnState& st, const unsigned char* sK, const unsigned char* sV, const bf16x8 (&q)[2], const FragBase& fb, int g, bool lane_ok, bool check, MF valid) {
    const bool first = (st.m == NEG_INF);
    const float cm = lane_ok ? (first ? 0.f : -st.m) : NEG_INF;
    f32x4 s[4];
    qk_tile_c(s, sK, q, fb, (f32x4){cm, cm, cm, cm});
    if (check) {
#pragma unroll
        for (int ni = 0; ni < 4; ++ni)
#pragma unroll
            for (int r = 0; r < 4; ++r) { if (!valid(KEY_OF(ni, g, r))) s[ni][r] = NEG_INF; }
    }
    const float gr = xr_max(max16m(s));
    if (__any(first ? (gr > NEG_INF) : (gr > RESCALE_THR))) {
        const float sh = (gr == NEG_INF) ? 0.f : (first ? gr : fmaxf(gr, 0.f));
        const float alpha = first ? 1.f : EXP2(-sh);
        st.m = (gr == NEG_INF) ? st.m : (first ? 0.f : st.m) + sh;
        const f32x4 nsh = (f32x4){-sh, -sh, -sh, -sh};
#pragma unroll
        for (int ni = 0; ni < 4; ++ni) s[ni] = s[ni] + nsh;
        st.l *= alpha;
#pragma unroll
        for (int mi = 0; mi < 4; ++mi) st.o[mi] *= alpha;
    }
    f32x4 av = (f32x4){0.f, 0.f, 0.f, 0.f};
#pragma unroll
    for (int ni = 0; ni < 4; ++ni) {
#pragma unroll
        for (int r = 0; r < 4; ++r) s[ni][r] = EXP2(s[ni][r]);
        av += s[ni];
    }
    st.l += xr_sum((av[0] + av[1]) + (av[2] + av[3]));
    bf16x8 pf[2];
    p_pack(pf, s);
    pv_tile(st.o, sV, pf, fb);
}

template <class MFA, class MFB>
__device__ __forceinline__ void attn_tile2(AttnState& st, const unsigned char* sKa, const unsigned char* sKb, const bf16x8 (&q)[2], const FragBase& fb, int g,
                                           bool okA, bool chkA, MFA validA, bool okB, bool chkB, MFB validB) {
    const bool first = (st.m == NEG_INF);
    const float cbase = first ? 0.f : -st.m, cmA = okA ? cbase : NEG_INF, cmB = okB ? cbase : NEG_INF;
    f32x4 sa[4], sb[4];
    qk_tile_c(sa, sKa, q, fb, (f32x4){cmA, cmA, cmA, cmA});
    qk_tile_c(sb, sKb, q, fb, (f32x4){cmB, cmB, cmB, cmB});
    if (chkA) {
#pragma unroll
        for (int ni = 0; ni < 4; ++ni)
#pragma unroll
            for (int r = 0; r < 4; ++r) { if (!validA(KEY_OF(ni, g, r))) sa[ni][r] = NEG_INF; }
    }
    if (chkB) {
#pragma unroll
        for (int ni = 0; ni < 4; ++ni)
#pragma unroll
            for (int r = 0; r < 4; ++r) { if (!validB(KEY_OF(ni, g, r))) sb[ni][r] = NEG_INF; }
    }
    const float gr = xr_max(MAXM(max16m(sa), max16m(sb)));
    if (__any(first ? (gr > NEG_INF) : (gr > RESCALE_THR))) {
        const float sh = (gr == NEG_INF) ? 0.f : (first ? gr : fmaxf(gr, 0.f));
        const float alpha = first ? 1.f : EXP2(-sh);
        st.m = (gr == NEG_INF) ? st.m : (first ? 0.f : st.m) + sh;
        const f32x4 nsh = (f32x4){-sh, -sh, -sh, -sh};
#pragma unroll
        for (int ni = 0; ni < 4; ++ni) { sa[ni] = sa[ni] + nsh; sb[ni] = sb[ni] + nsh; }
        st.l *= alpha;
#pragma unroll
        for (int mi = 0; mi < 4; ++mi) st.o[mi] *= alpha;
    }
    f32x4 av = (f32x4){0.f, 0.f, 0.f, 0.f};
#pragma unroll
    for (int ni = 0; ni < 4; ++ni) {
#pragma unroll
        for (int r = 0; r < 4; ++r) { sa[ni][r] = EXP2(sa[ni][r]); sb[ni][r] = EXP2(sb[ni][r]); }
        av += sa[ni]; av += sb[ni];
    }
    st.l += xr_sum((av[0] + av[1]) + (av[2] + av[3]));
    bf16x8 pfa[2], pfb[2];
    p_pack(pfa, sa); p_pack(pfb, sb);
    pv_tile(st.o, sKa + 8192, pfa, fb);
    pv_tile(st.o, sKb + 8192, pfb, fb);
}

__device__ __forceinline__ void tile_ld(const int t, const bf16_t* base, long ld, uint4& r0, uint4& r1v) {
    const int c = t & 7, row = t >> 3;
    r0 = *(const uint4*)(base + (long)row * ld + c * 8); r1v = *(const uint4*)(base + (long)(row + 32) * ld + c * 8);
}
__device__ __forceinline__ void tile_st(const int t, unsigned char* sX, const uint4& r0, const uint4& r1v) {
    const int c = t & 7, row = t >> 3;
    *(uint4*)(sX + swz(row, c)) = r0; *(uint4*)(sX + swz(row + 32, c)) = r1v;
}
template <class NF, class TF, class MF>
__device__ __forceinline__ void attn_run(const int t, AttnState& st, unsigned char* ring, const bf16_t* kbase, long kld, const bf16_t* vtbase, long vld,
                                         const bf16x8 (&q)[2], int fr, int g, NF next, TF tinfo, MF mask) {
    const int lane = t & 63, wid = __builtin_amdgcn_readfirstlane(t >> 6);
    unsigned ko[2], vo[2];
#pragma unroll
    for (int j = 0; j < 2; ++j) { const int row = 8 * (wid * 2 + j) + (lane >> 3); const int c = ((lane & 7) ^ ((row >> 2) ^ row)) & 7;
        ko[j] = (unsigned)(row * kld + c * 8); vo[j] = (unsigned)(row * vld + c * 8); }
    auto issue = [&](int kt, int stage) {
        unsigned char* sK = ring + stage * 16384 + wid * 2048; unsigned char* sV = sK + 8192;
        const bf16_t* kb = kbase + (long)kt * 64 * kld; const bf16_t* vb = vtbase + (long)kt * 64;
#pragma unroll
        for (int j = 0; j < 2; ++j) { glds16(kb + ko[j], sK + j * 1024); glds16(vb + vo[j], sV + j * 1024); }
    };
    const FragBase fb = frag_base(fr, g);
    int kA = __builtin_amdgcn_readfirstlane(next(-1)), kB = (kA >= 0) ? __builtin_amdgcn_readfirstlane(next(kA)) : -1;
    if (kA >= 0) issue(kA, 0);
    if (kB >= 0) issue(kB, 1);
    int i = 0;
    while (kA >= 0) {
        const int kC = (kB >= 0) ? __builtin_amdgcn_readfirstlane(next(kB)) : -1, kD = (kC >= 0) ? __builtin_amdgcn_readfirstlane(next(kC)) : -1;
        asm volatile("s_waitcnt vmcnt(0)" ::: "memory");
        asm volatile("s_waitcnt lgkmcnt(0)" ::: "memory"); __builtin_amdgcn_s_barrier(); asm volatile("" ::: "memory");
        const int sb = (i & 1) * 2;
        if (kC >= 0) issue(kC, sb ^ 2);
        if (kD >= 0) issue(kD, (sb ^ 2) + 1);
        const unsigned char* sKa = ring + sb * 16384; const unsigned char* sKb = sKa + 16384;
        bool okA, chkA; tinfo(kA, okA, chkA);
        if (kB >= 0) {
            bool okB, chkB; tinfo(kB, okB, chkB);
            attn_tile2(st, sKa, sKb, q, fb, g, okA, chkA, [&](int kl) { return mask(kA, kl); }, okB, chkB, [&](int kl) { return mask(kB, kl); });
        } else {
            attn_tile(st, sKa, sKa + 8192, q, fb, g, okA, chkA, [&](int kl) { return mask(kA, kl); });
        }
        kA = kC; kB = kD; ++i;
    }
    asm volatile("s_waitcnt lgkmcnt(0)" ::: "memory"); __builtin_amdgcn_s_barrier(); asm volatile("" ::: "memory");
}


template <class MF0, class MF1>
__device__ __forceinline__ void attn_tile_g2(AttnState& st0, AttnState& st1, const unsigned char* sK, const unsigned char* sV, const bf16x8 (&q0)[2], const bf16x8 (&q1)[2],
                                             const FragBase& fb, int g, bool ok0, bool chk0, MF0 valid0, bool ok1, bool chk1, MF1 valid1) {
    const bool first0 = (st0.m == NEG_INF), first1 = (st1.m == NEG_INF);
    const float cm0 = ok0 ? (first0 ? 0.f : -st0.m) : NEG_INF, cm1 = ok1 ? (first1 ? 0.f : -st1.m) : NEG_INF;
    const f32x4 c0 = (f32x4){cm0, cm0, cm0, cm0}, c1 = (f32x4){cm1, cm1, cm1, cm1};
    f32x4 s0[4], s1[4];
#pragma unroll
    for (int ni = 0; ni < 4; ++ni) {
        s0[ni] = c0; s1[ni] = c1;
#pragma unroll
        for (int ks = 0; ks < 2; ++ks) {
            const bf16x8 kf = *(const bf16x8*)(sK + (ni >> 1) * 4096 + (ni & 1) * 512 + (fb.kb ^ ((ni & 1) * 80) ^ (ks * 64)));
            s0[ni] = __builtin_amdgcn_mfma_f32_16x16x32_bf16(kf, q0[ks], s0[ni], 0, 0, 0);
            s1[ni] = __builtin_amdgcn_mfma_f32_16x16x32_bf16(kf, q1[ks], s1[ni], 0, 0, 0);
        }
    }
    if (chk0) {
#pragma unroll
        for (int ni = 0; ni < 4; ++ni)
#pragma unroll
            for (int r = 0; r < 4; ++r) { if (!valid0(KEY_OF(ni, g, r))) s0[ni][r] = NEG_INF; }
    }
    if (chk1) {
#pragma unroll
        for (int ni = 0; ni < 4; ++ni)
#pragma unroll
            for (int r = 0; r < 4; ++r) { if (!valid1(KEY_OF(ni, g, r))) s1[ni][r] = NEG_INF; }
    }
    const float g0 = xr_max(max16m(s0)), g1 = xr_max(max16m(s1));
    if (__any((first0 ? (g0 > NEG_INF) : (g0 > RESCALE_THR)) || (first1 ? (g1 > NEG_INF) : (g1 > RESCALE_THR)))) {
        const float sh0 = (g0 == NEG_INF) ? 0.f : (first0 ? g0 : fmaxf(g0, 0.f)), sh1 = (g1 == NEG_INF) ? 0.f : (first1 ? g1 : fmaxf(g1, 0.f));
        const float alpha0 = first0 ? 1.f : EXP2(-sh0), alpha1 = first1 ? 1.f : EXP2(-sh1);
        st0.m = (g0 == NEG_INF) ? st0.m : (first0 ? 0.f : st0.m) + sh0; st1.m = (g1 == NEG_INF) ? st1.m : (first1 ? 0.f : st1.m) + sh1;
        const f32x4 nsh0 = (f32x4){-sh0, -sh0, -sh0, -sh0}, nsh1 = (f32x4){-sh1, -sh1, -sh1, -sh1};
#pragma unroll
        for (int ni = 0; ni < 4; ++ni) { s0[ni] = s0[ni] + nsh0; s1[ni] = s1[ni] + nsh1; }
        st0.l *= alpha0; st1.l *= alpha1;
#pragma unroll
        for (int mi = 0; mi < 4; ++mi) { st0.o[mi] *= alpha0; st1.o[mi] *= alpha1; }
    }
    f32x4 a0 = (f32x4){0.f, 0.f, 0.f, 0.f}, a1 = a0;
#pragma unroll
    for (int ni = 0; ni < 4; ++ni) {
#pragma unroll
        for (int r = 0; r < 4; ++r) { s0[ni][r] = EXP2(s0[ni][r]); s1[ni][r] = EXP2(s1[ni][r]); }
        a0 += s0[ni]; a1 += s1[ni];
    }
    st0.l += xr_sum((a0[0] + a0[1]) + (a0[2] + a0[3])); st1.l += xr_sum((a1[0] + a1[1]) + (a1[2] + a1[3]));
    bf16x8 pf0[2], pf1[2];
    p_pack(pf0, s0); p_pack(pf1, s1);
    bf16x8 vf[2][4];
#pragma unroll
    for (int kk = 0; kk < 2; ++kk)
#pragma unroll
        for (int mi = 0; mi < 4; ++mi) vf[kk][mi] = *(const bf16x8*)(sV + mi * 2048 + (fb.vb ^ (((kk ^ mi) & 1) << 6)));
#pragma unroll
    for (int kk = 0; kk < 2; ++kk)
#pragma unroll
        for (int mi = 0; mi < 4; ++mi) {
            st0.o[mi] = __builtin_amdgcn_mfma_f32_16x16x32_bf16(vf[kk][mi], pf0[kk], st0.o[mi], 0, 0, 0);
            st1.o[mi] = __builtin_amdgcn_mfma_f32_16x16x32_bf16(vf[kk][mi], pf1[kk], st1.o[mi], 0, 0, 0);
        }
}
template <class NF, class TF, class MF0, class MF1>
__device__ __forceinline__ void attn_run_g2(const int t, AttnState& st0, AttnState& st1, unsigned char* ring, const bf16_t* kbase, long kld, const bf16_t* vtbase, long vld,
                                            const bf16x8 (&q0)[2], const bf16x8 (&q1)[2], int fr, int g, NF next, TF tinfo, MF0 mask0, MF1 mask1) {
    const int lane = t & 63, wid = __builtin_amdgcn_readfirstlane(t >> 6);
    unsigned ko[2], vo[2];
#pragma unroll
    for (int j = 0; j < 2; ++j) { const int row = 8 * (wid * 2 + j) + (lane >> 3); const int c = ((lane & 7) ^ ((row >> 2) ^ row)) & 7;
        ko[j] = (unsigned)(row * kld + c * 8); vo[j] = (unsigned)(row * vld + c * 8); }
    auto issue = [&](int kt, int stage) {
        unsigned char* sK = ring + stage * 16384 + wid * 2048; unsigned char* sV = sK + 8192;
        const bf16_t* kb = kbase + (long)kt * 64 * kld; const bf16_t* vb = vtbase + (long)kt * 64;
#pragma unroll
        for (int j = 0; j < 2; ++j) { glds16(kb + ko[j], sK + j * 1024); glds16(vb + vo[j], sV + j * 1024); }
    };
    const FragBase fb = frag_base(fr, g);
    int kA = __builtin_amdgcn_readfirstlane(next(-1)), kB = (kA >= 0) ? __builtin_amdgcn_readfirstlane(next(kA)) : -1;
    if (kA >= 0) issue(kA, 0);
    if (kB >= 0) issue(kB, 1);
#define G2_STEP(SB_) { \
        const int kC = (kB >= 0) ? __builtin_amdgcn_readfirstlane(next(kB)) : -1, kD = (kC >= 0) ? __builtin_amdgcn_readfirstlane(next(kC)) : -1; \
        asm volatile("s_waitcnt vmcnt(0)" ::: "memory"); \
        asm volatile("s_waitcnt lgkmcnt(0)" ::: "memory"); __builtin_amdgcn_s_barrier(); asm volatile("" ::: "memory"); \
        if (kC >= 0) issue(kC, (SB_) ^ 2); \
        if (kD >= 0) issue(kD, ((SB_) ^ 2) + 1); \
        const unsigned char* sKa = ring + (SB_) * 16384; const unsigned char* sKb = sKa + 16384; \
        { bool ok0, chk0, ok1, chk1; tinfo(kA, ok0, chk0, ok1, chk1); \
          attn_tile_g2(st0, st1, sKa, sKa + 8192, q0, q1, fb, g, ok0, chk0, [&](int kl) { return mask0(kA, kl); }, ok1, chk1, [&](int kl) { return mask1(kA, kl); }); } \
        if (kB >= 0) { bool ok0, chk0, ok1, chk1; tinfo(kB, ok0, chk0, ok1, chk1); \
          attn_tile_g2(st0, st1, sKb, sKb + 8192, q0, q1, fb, g, ok0, chk0, [&](int kl) { return mask0(kB, kl); }, ok1, chk1, [&](int kl) { return mask1(kB, kl); }); } \
        kA = kC; kB = kD; }
    while (kA >= 0) {
        G2_STEP(0)
        if (kA < 0) break;
        G2_STEP(2)
    }
#undef G2_STEP
    asm volatile("s_waitcnt lgkmcnt(0)" ::: "memory"); __builtin_amdgcn_s_barrier(); asm volatile("" ::: "memory");
}

__device__ __forceinline__ unsigned units_in(int bid, int G, int lo, int hi) {
    const int a = lo > bid ? (lo - bid + G - 1) / G : 0, b = hi > bid ? (hi - bid + G - 1) / G : 0; return (unsigned)(b - a); }

__global__ void __launch_bounds__(256, 2) fwd_kernel(Params p) {
    extern __shared__ __attribute__((aligned(16))) unsigned char smem[];
    const int G = gridDim.x;
    volatile LAS unsigned* xbw = (volatile LAS unsigned*)(smem + SMEM_BYTES - 16);
    if (threadIdx.x == 0) { xbw[0] = 0u; xbw[1] = 0u; xbw[2] = 0u; xbw[3] = 0u; }
    __syncthreads();
    (void)xcd_barrier_post((unsigned*)(p.ws + WS_BAR), xbw);
    const int wid_s = __builtin_amdgcn_readfirstlane((int)(threadIdx.x >> 6));
#define GRID_BARRIER() do { XcdBarrier b_; b_.bar = (unsigned*)(p.ws + WS_BAR); b_.x = xb_xcc_id(); b_.st = (volatile LAS unsigned*)(smem + SMEM_BYTES - 16); xcd_barrier(b_); } while (0)
#define PHASE_BEGIN int t; asm volatile("v_mbcnt_lo_u32_b32 %0, -1, 0\n\tv_mbcnt_hi_u32_b32 %0, -1, %0" : "=v"(t)); t += wid_s * 64; asm volatile("" : "+v"(t)); \
                    const int lane = t & 63, wid = wid_s; (void)lane; (void)wid; \
                    int bid = (int)blockIdx.x; asm volatile("" : "+s"(bid)); size_t wso_ = 0; asm volatile("" : "+s"(wso_)); unsigned char* ws = p.ws + wso_;
#define Q_NEXT(ctr_, var_) { __syncthreads(); if (t == 0) *(volatile int*)(smem + SMEM_BYTES - 32) = (int)atomicAdd((ctr_), 1u); __syncthreads(); var_ = __builtin_amdgcn_readfirstlane(*(volatile int*)(smem + SMEM_BYTES - 32)); }
#define FLAG_PUBLISH(flag_, n_) do { asm volatile("s_waitcnt vmcnt(0)" ::: "memory"); __syncthreads(); \
    if (t == 0) { __builtin_amdgcn_fence(__ATOMIC_RELEASE, "agent"); asm volatile("s_waitcnt vmcnt(0)" ::: "memory"); (void)xb_add((flag_), (n_)); } } while (0)
#define FLAG_WAIT(flag_, n_) do { if (t == 0) { unsigned* bar_ = (unsigned*)(p.ws + WS_BAR); unsigned* fl_ = (flag_); XB_SPIN(xb_ld(fl_) < (n_), bar_); \
    __builtin_amdgcn_fence(__ATOMIC_ACQUIRE, "agent"); asm volatile("s_waitcnt vmcnt(0)" ::: "memory"); } __syncthreads(); } while (0)
#define XPUB_WORD(L_, pt_) ((unsigned*)(p.ws + WS_QCTR + 8192 + (((size_t)(L_) * 4 + (pt_)) * 16 + xb_xcc_id()) * 64))
#define XCD_ARRIVE(L_, pt_, inc_, onlast_) do { asm volatile("s_waitcnt vmcnt(0)" ::: "memory"); __syncthreads(); \
    if (t == 0) { const unsigned nloc_ = *(volatile LAS unsigned*)(smem + SMEM_BYTES - 16); const unsigned inc2_ = (1u << 24) | (inc_); \
        const unsigned tot_ = xb_add(XPUB_WORD(L_, pt_), inc2_) + inc2_; \
        if ((tot_ >> 24) == nloc_) { __builtin_amdgcn_fence(__ATOMIC_RELEASE, "agent"); asm volatile("s_waitcnt vmcnt(0)" ::: "memory"); onlast_; } } } while (0)
#define PHASE_BEGIN_L PHASE_BEGIN int Lx_ = Lrun; asm volatile("" : "+s"(Lx_)); const int L = Lx_; \
                    const float* xin = (L == 0) ? p.x : (const float*)xB; const float* modL = modb + (size_t)L * 2 * 6144; (void)xin; (void)modL;

    { PHASE_BEGIN
    for (int u = bid; u < 384 + 256 + 2 * 1344 + 32; u += G) {
        if (u >= 384 + 256 + 2 * 1344) {
            const int w = u - (384 + 256 + 2 * 1344), lk = w >> 3, ch = w & 7;
            const float* w1f = p.cmp_w1 + (size_t)lk * 2048 * 128; const float* pef = p.cmp_pe + (size_t)lk * 2048;
            float* red = (float*)smem;
            const int j = t & 127, hf = t >> 7; float s = 0.f;
#pragma unroll 8
            for (int k = ch * 256 + hf * 128; k < ch * 256 + hf * 128 + 128; ++k) s += pef[k] * w1f[(size_t)k * 128 + j];
            red[t] = s;
            __syncthreads();
            if (t < 128) pbias[(size_t)w * 128 + t] = red[t] + red[128 + t];
            __syncthreads();
        } else if (u >= 384 + 256) {
            const int w = u - 640, l = w / 1344; int r = w % 1344;
            const float* src; long ldn; int nval, kb, nb; bf16_t* dst; long dK;
            if (r < 704)       { kb = r / 44; nb = r % 44; src = p.w_in + (size_t)l * 1024 * INCOLS; ldn = INCOLS; nval = INCOLS; dst = WTL(l) + WT_IN; dK = 1024; }
            else if (r < 960)  { r -= 704; kb = r >> 4; nb = r & 15; src = p.w_out + (size_t)l * 1048576; ldn = 1024; nval = 1024; dst = WTL(l) + WT_OUT; dK = 1024; }
            else if (r < 1024) { r -= 960; kb = r >> 2; nb = r & 3; src = p.w_router + (size_t)l * 262144; ldn = 256; nval = 256; dst = WTL(l) + WT_R; dK = 1024; }
            else if (r < 1088) { r -= 1024; kb = r >> 2; nb = r & 3; src = p.sh_gate + (size_t)l * 262144; ldn = 256; nval = 256; dst = WTL(l) + WT_SGU; dK = 1024; }
            else if (r < 1152) { r -= 1088; kb = r >> 2; nb = r & 3; src = p.sh_up + (size_t)l * 262144; ldn = 256; nval = 256; dst = WTL(l) + WT_SGU + 262144; dK = 1024; }
            else if (r < 1216) { r -= 1152; kb = r >> 4; nb = r & 15; src = p.sh_down + (size_t)l * 262144; ldn = 1024; nval = 1024; dst = WTL(l) + WT_SD; dK = 256; }
            else               { r -= 1216; const int kv = r >> 6; r &= 63; kb = r >> 1; nb = r & 1; src = p.cmp_w1 + ((size_t)l * 2 + kv) * 262144; ldn = 128; nval = 128; dst = WTL(l) + WT_W1 + (size_t)kv * 262144; dK = 2048; }
            int nv = nval - nb * 64; nv = nv < 0 ? 0 : (nv > 64 ? 64 : nv);
            conv_block(src + (size_t)kb * 64 * ldn + nb * 64, ldn, nv, dst + (size_t)nb * 64 * dK + kb * 64, dK, smem, t);
        } else if (u < 384) {
            const int l = u / 192, j0 = (u % 192) * 32;
            float* sc = (float*)smem;
            float* red = sc + 2048;
            for (int i = t; i < 2048; i += 256) sc[i] = siluf_(p.c[i]);
            __syncthreads();
            const int c = t & 31, rg = t >> 5;
            const float* w = p.w_ada + (size_t)l * 1024 * 6144 + j0 + c;
            float s0 = 0.f, s1 = 0.f;
#pragma unroll 8
            for (int i = rg * 128; i < rg * 128 + 128; ++i) { const float wv = w[(size_t)i * 6144]; s0 += sc[i] * wv; s1 += sc[1024 + i] * wv; }
            red[(rg * 32 + c) * 2] = s0; red[(rg * 32 + c) * 2 + 1] = s1;
            __syncthreads();
            if (t < 64) {
                const int cc = t & 31, b = t >> 5;
                float s = 0.f;
                for (int r = 0; r < 8; ++r) s += red[(r * 32 + cc) * 2 + b];
                modb[(l * 2 + b) * 6144 + j0 + cc] = s + p.b_ada[l * 6144 + j0 + cc];
            }
            __syncthreads();
        } else {
            const int idx = (u - 384) * 256 + t, pos = idx >> 3, i = idx & 7;
            const float inv = powf(500000.0f, -(float)i / 8.0f);
            const float ang = (float)pos * inv;
            float sn, cs; sincosf(ang, &sn, &cs);
            rope[idx] = make_float2(cs, sn);
        }
    }
    }
    GRID_BARRIER();

    { PHASE_BEGIN
        const float4* x4 = (const float4*)p.x;
        for (long i = (long)bid * 256 + t; i < (long)NTOK * 256; i += (long)G * 256) {
            const int tok = (int)(i >> 8), d = (int)(i & 255) * 4, b = tok >> 13;
            const float4 xv = x4[i];
            const float4 sh = *(const float4*)(modb + (0 * 2 + b) * 6144 + d), sc = *(const float4*)(modb + (0 * 2 + b) * 6144 + 1024 + d);
            uint2 o; o.x = pack2(xv.x * (1.f + sc.x) + sh.x, xv.y * (1.f + sc.y) + sh.y); o.y = pack2(xv.z * (1.f + sc.z) + sh.z, xv.w * (1.f + sc.w) + sh.w);
            *(uint2*)(hbuf + (size_t)tok * 1024 + d) = o;
        }
    }
    GRID_BARRIER();

    for (int Lrun = 0; Lrun < NLAYER; ++Lrun) {

        { PHASE_BEGIN_L
            const bf16_t* W = WTL(L) + WT_IN;
            for (int u = bid; u < 128 * 22; u += G) {
                const int mt = u / 22, nt = u % 22, row0 = mt * 128, n0 = nt * 128;
                gemm_dma<128, 2>(smem, t, 16, hbuf + (size_t)row0 * 1024, [&](int r) { return (unsigned)(r * 1024); }, 64,
                    W + (size_t)n0 * 1024, [&](int r) { return (unsigned)(r * 1024); },
                    [&](f32x4 (&acc)[4][4], int wr, int wc, int fr, int g) {
#pragma unroll
                        for (int m = 0; m < 4; ++m) {
                            const int tok = row0 + wr * 64 + m * 16 + fr, b = tok >> 13, pos = tok & 8191;
#pragma unroll
                            for (int n = 0; n < 4; ++n) {
                                const int c16 = n0 + wc * 64 + n * 16;
                                if (c16 >= INCOLS) continue;
                                const int c0 = c16 + 4 * g;
                                f32x4 v = acc[m][n];
                                const bool ropeseg = (c16 < 512) || (c16 >= 768 && c16 < 1024) || (c16 >= 1152 && c16 < 1216) || (c16 >= 1280 && c16 < 1344);
                                f32x4 vr = v;
                                if (ropeseg && ((c16 & 63) == 0)) {
#pragma unroll
                                    for (int r = 0; r < 4; ++r) {
                                        const float other = __shfl_xor(v[r], 32);
                                        const float2 cs = rope[pos * 8 + ((4 * g + r) & 7)];
                                        vr[r] = (g < 2) ? (v[r] * cs.x - other * cs.y) : (other * cs.y + v[r] * cs.x);
                                    }
                                }
                                if (c0 >= INCOLS) continue;
                                if (c16 < 256) { vr *= 0.18033688f; }
                                else if (c16 >= 768 && c16 < 1024) { v *= 0.18033688f; vr *= 0.18033688f; }
                                else if (c0 >= 1676 && c0 < 1932) { vr *= 0.125f; }
                                uint2 o; o.x = pack2(vr[0], vr[1]); o.y = pack2(vr[2], vr[3]);
                                if (c16 >= 512 && c16 < 768) {
                                    const int hh = (c0 - 512) >> 6, dd = (c0 - 512) & 63;
                                    bf16_t* dst = vtm + ((size_t)(b * 4 + hh) * 64 + dd) * 8192 + pos;
                                    dst[0] = (bf16_t)(o.x & 0xffff); dst[8192] = (bf16_t)(o.x >> 16); dst[2 * 8192] = (bf16_t)(o.y & 0xffff); dst[3 * 8192] = (bf16_t)(o.y >> 16);
                                } else if (c16 >= 1216 && c16 < 1280) {
                                    const int dd = c0 - 1216;
                                    bf16_t* dst = vts + ((size_t)b * 64 + dd) * 8192 + pos;
                                    dst[0] = (bf16_t)(o.x & 0xffff); dst[8192] = (bf16_t)(o.x >> 16); dst[2 * 8192] = (bf16_t)(o.y & 0xffff); dst[3 * 8192] = (bf16_t)(o.y >> 16);
                                } else if (c16 >= 1344 && c16 < 1408) {
                                    const int dd = c0 - 1344;
                                    bf16_t* dst = vtw + ((size_t)b * 64 + dd) * 8192 + pos;
                                    dst[0] = (bf16_t)(o.x & 0xffff); dst[8192] = (bf16_t)(o.x >> 16); dst[2 * 8192] = (bf16_t)(o.y & 0xffff); dst[3 * 8192] = (bf16_t)(o.y >> 16);
                                } else if (c16 >= 768 && c16 < 1024) {
                                    uint2 oraw; oraw.x = pack2(v[0], v[1]); oraw.y = pack2(v[2], v[3]);
                                    *(uint2*)(zb + (size_t)tok * ZLD + c0) = oraw;
                                    *(uint2*)(qrot + (size_t)tok * 256 + (c0 - 768)) = o;
                                } else {
                                    const int zc = c0 + (c0 >= 1420 ? 4 : 0);
                                    *(uint2*)(zb + (size_t)tok * ZLD + zc) = o;
                                }
                            }
                        }
                    });
            }
        }
        GRID_BARRIER();

        { PHASE_BEGIN_L
            const int NB2 = 128;
            for (int u = bid; u < NB2; u += G) {
                {
                    const int kv = u >> 6, rt = (u >> 3) & 7, ks = u & 7;
                    const bf16_t* w1 = WTL(L) + WT_W1 + (size_t)kv * 128 * 2048 + ks * 256;
                    const int zcol = kv ? Z_VC : Z_KC;
                    float* dstp = cpart + ((size_t)(ks * 2 + kv) * 1024 + rt * 128) * 128;
                    gemm_dma<128, 2>(smem, t, 4, zb + zcol + (size_t)ks * 4 * ZLD,
                        [&](int r) { const int R = rt * 128 + r; if (R >= 1022) return 0u; const int b = R / 511, n = R % 511;
                                     return (unsigned)((b * 8192 + 16 * n) * ZLD); }, ZLD,
                        w1, [&](int r) { return (unsigned)(r * 2048); },
                        [&](f32x4 (&acc)[4][4], int wr, int wc, int fr, int g) {
#pragma unroll
                            for (int m = 0; m < 4; ++m)
#pragma unroll
                                for (int n = 0; n < 4; ++n) {
                                    const int row = wr * 64 + m * 16 + fr, col = wc * 64 + n * 16 + 4 * g;
                                    *(float4*)(dstp + row * 128 + col) = make_float4(acc[m][n][0], acc[m][n][1], acc[m][n][2], acc[m][n][3]);
                                }
                        });
                }
            }
        }
        { PHASE_BEGIN_L
            const int NB2 = 128, NB1 = 256;
            for (int u = bid; u < NB2 + NB1; u += G) {
                if (u < NB2) continue;
                {
                    const int v = u - NB2, b = v >> 7, h = (v >> 5) & 3, blk = v & 31;
                    float* red = (float*)smem;
                    const int d = t & 63, rg = t >> 6;
                    const bf16_t* src = zb + ((size_t)b * 8192 + blk * 256 + rg * 64) * ZLD + Z_MK + h * 64 + d;
                    float s = 0.f;
                    for (int i = 0; i < 64; ++i) s += bf2f(src[(size_t)i * ZLD]);
                    red[rg * 64 + d] = s;
                    __syncthreads();
                    if (t < 64) kmean[((size_t)(b * 4 + h) * 32 + blk) * 64 + t] = (red[t] + red[64 + t] + red[128 + t] + red[192 + t]) * (1.f / 256.f);
                    __syncthreads();
                }
            }
            { const unsigned n1 = units_in(bid, G, NB2, NB2 + NB1); XCD_ARRIVE(L, 0, n1, (void)xb_add(QCTR(L, 6), tot_ & 0xffffffu)); }
        }
        { PHASE_BEGIN_L
            const int NB2 = 128, NB1 = 256, NB3 = 1024;
            for (int u = bid; u < NB2 + NB1 + NB3; u += G) {
                if (u < NB2 + NB1) continue;
                {
                    const int v = u - NB2 - NB1, b = v >> 9, h = (v >> 7) & 3, c = v & 127;
                    const size_t tok0 = (size_t)b * 8192 + c * 64;
                    float* la = (float*)smem;
                    float* ke = la + 4096;
                    float* vv = ke + 4096;
                    float* wa = vv + 4096;
                    float* ga = wa + 1024;
                    const float* gwa = p.gla_wa + (size_t)L * 16 * 256, *gba = p.gla_ba + (size_t)L * 256;
                    for (int i = t; i < 1024; i += 256) { const int r = i >> 6, d = i & 63; wa[i] = gwa[r * 256 + h * 64 + d]; }
                    for (int i = t; i < 1024; i += 256) { const int r = i >> 4, k = i & 15; ga[i] = bf2f(zb[(tok0 + r) * ZLD + Z_GA + k]); }
                    __syncthreads();
                    {
                        const int d = t & 63, ig = t >> 6;
                        const float bias = gba[h * 64 + d];
                        for (int i = ig * 16; i < ig * 16 + 16; ++i) {
                            float s = bias;
#pragma unroll
                            for (int k = 0; k < 16; ++k) s += ga[i * 16 + k] * wa[k * 64 + d];
                            const float ls = fminf(s, 0.f) - log1pf(__expf(-fabsf(s)));
                            la[i * 64 + d] = ls * (1.f / 16.f);
                        }
                    }
                    __syncthreads();
                    if (t < 64) { float run = 0.f; for (int i = 0; i < 64; ++i) { run += la[i * 64 + t]; la[i * 64 + t] = run; } }
                    __syncthreads();
                    for (int i = t; i < 4096; i += 256) {
                        const int j = i >> 6, d = i & 63;
                        const float bj = la[i], be = la[63 * 64 + d];
                        bcum[(tok0 + j) * 256 + h * 64 + d] = bj;
                        ke[i] = bf2f(zb[(tok0 + j) * ZLD + Z_GK + h * 64 + d]) * __expf(be - bj);
                        vv[i] = bf2f(zb[(tok0 + j) * ZLD + Z_GV + h * 64 + d]);
                    }
                    if (t < 64) aend[((size_t)(b * 4 + h) * 128 + c) * 64 + t] = __expf(la[63 * 64 + t]);
                    __syncthreads();
                    {
                        const int fr = lane & 15, g = lane >> 4;
                        f32x4 ua[4];
#pragma unroll
                        for (int n = 0; n < 4; ++n) ua[n] = (f32x4){0.f, 0.f, 0.f, 0.f};
                        for (int j0 = 0; j0 < 64; j0 += 4) {
                            const float a = ke[(j0 + g) * 64 + 16 * wid + fr];
#pragma unroll
                            for (int n = 0; n < 4; ++n) ua[n] = __builtin_amdgcn_mfma_f32_16x16x4f32(a, vv[(j0 + g) * 64 + 16 * n + fr], ua[n], 0, 0, 0);
                        }
                        float* dst = Ub + ((size_t)(b * 4 + h) * 128 + c) * 4096;
#pragma unroll
                        for (int n = 0; n < 4; ++n)
#pragma unroll
                            for (int r = 0; r < 4; ++r) dst[(16 * wid + 4 * g + r) * 64 + 16 * n + fr] = ua[n][r];
                    }
                    __syncthreads();
                }
            }
        }
        { PHASE_BEGIN_L
            const int NB2 = 128, NB1 = 256, NB3 = 1024, NB4 = 1024;
            for (int u = bid; u < NB2 + NB1 + NB3 + NB4; u += G) {
                if (u < NB2 + NB1 + NB3) continue;
                {
                    const int v = u - NB2 - NB1 - NB3, tok0 = v * 16, b = tok0 >> 13, pos0 = tok0 & 8191;
                    float* ul = (float*)smem;
                    float* pl = ul + 31 * 256;
                    for (int i = t; i < 31 * 256; i += 256) {
                        const int r = i >> 8, cidx = i & 255, pos = pos0 - 15 + r;
                        ul[i] = (pos >= 0) ? bf2f(zb[((size_t)b * 8192 + pos) * ZLD + Z_POOL + cidx]) : 0.f;
                    }
                    __syncthreads();
                    {
                        const int cidx = t, gq = cidx >> 6, w = 2 << gq;
                        for (int r = 0; r < 16; ++r) {
                            const int pos = pos0 + r;
                            float s = 0.f;
                            for (int k = 0; k < w; ++k) s += ul[(15 + r - k) * 256 + cidx];
                            const float cnt = (float)((pos + 1 < w) ? (pos + 1) : w);
                            pl[r * 256 + cidx] = s / cnt - ul[(15 + r) * 256 + cidx];
                        }
                    }
                    __syncthreads();
                    {
                        const int gq = t >> 6, d = t & 63;
                        const float* pw = p.pool_w + ((size_t)L * 4 + gq) * 4096;
                        float o[16];
#pragma unroll
                        for (int r = 0; r < 16; ++r) o[r] = 0.f;
                        for (int cc = 0; cc < 64; ++cc) {
                            const float wv = pw[cc * 64 + d];
#pragma unroll
                            for (int r = 0; r < 16; ++r) o[r] += pl[r * 256 + gq * 64 + cc] * wv;
                        }
                        const float ps = p.pool_scale[(size_t)L * 256 + t];
#pragma unroll
                        for (int r = 0; r < 16; ++r) ocat[(size_t)(tok0 + r) * 1024 + 512 + t] = f2bf(o[r] * ps);
                    }
                    __syncthreads();
                }
            }
            {
                const unsigned n2 = units_in(bid, G, 0, NB2), n3 = units_in(bid, G, NB2 + NB1, NB2 + NB1 + NB3);
                XCD_ARRIVE(L, 1, n2 | (n3 << 8), { (void)xb_add(QCTR(L, 7), tot_ & 0xffu); (void)xb_add(QCTR(L, 8), (tot_ >> 8) & 0xffffu); });
            }
        }

        { PHASE_BEGIN_L
            unsigned ndone = 0u;
            if (bid < 16) FLAG_WAIT(QCTR(L, 7), 128u);
            for (int u = bid; u < 16; u += G) {
                ++ndone;
                const int kv = u >> 3, rt = u & 7;
                const float* w2 = p.cmp_w2 + ((size_t)L * 2 + kv) * 128 * 64;
                bf16_t* hl = (bf16_t*)smem;
                float* pb = (float*)(smem + 32768);
                if (t < 128) { float s = 0.f; for (int c = 0; c < 8; ++c) s += pbias[((size_t)(L * 2 + kv) * 8 + c) * 128 + t]; pb[256 + t] = s; }
                __syncthreads();
                for (int i = t; i < 128 * 32; i += 256) {
                    const int row = i >> 5, c4 = (i & 31) * 4;
                    float4 a = make_float4(0.f, 0.f, 0.f, 0.f);
#pragma unroll
                    for (int ks = 0; ks < 8; ++ks) { const float4 pv = *(const float4*)(cpart + ((size_t)(ks * 2 + kv) * 1024 + rt * 128 + row) * 128 + c4); a.x += pv.x; a.y += pv.y; a.z += pv.z; a.w += pv.w; }
                    const float xs[4] = {a.x + pb[256 + c4], a.y + pb[256 + c4 + 1], a.z + pb[256 + c4 + 2], a.w + pb[256 + c4 + 3]}; float h4[4];
#pragma unroll
                    for (int r = 0; r < 4; ++r) { const float xx = xs[r]; const float u3 = 0.7978845608f * (xx + 0.044715f * xx * xx * xx); h4[r] = 0.5f * xx * (1.f + tanhf(u3)); }
                    uint2 o; o.x = pack2(h4[0], h4[1]); o.y = pack2(h4[2], h4[3]);
                    *(uint2*)(hl + row * 128 + c4) = o;
                }
                __syncthreads();
                {
                    const int d = t & 63, rg = t >> 6;
                    float o[32];
#pragma unroll
                    for (int r = 0; r < 32; ++r) o[r] = 0.f;
                    for (int j = 0; j < 128; ++j) {
                        const float wv = w2[j * 64 + d];
#pragma unroll
                        for (int r = 0; r < 32; ++r) o[r] += bf2f(hl[(rg * 32 + r) * 128 + j]) * wv;
                    }
#pragma unroll
                    for (int r = 0; r < 32; ++r) {
                        const int R = rt * 128 + rg * 32 + r;
                        int b, n; float val = o[r];
                        if (R < 1022) { b = R / 511; n = R % 511; } else { b = R - 1022; n = 511; val = 0.f; }
                        if (kv == 0) kcb[((size_t)b * 512 + n) * 64 + d] = f2bf(val);
                        else vct[((size_t)b * 64 + d) * 512 + n] = f2bf(val);
                    }
                }
                __syncthreads();
            }
            XCD_ARRIVE(L, 2, ndone, (void)xb_add(QCTR(L, 4), tot_ & 0xffffffu));
        }
        { PHASE_BEGIN_L
            const int NC1 = 128;
            unsigned ndone = 0u;
            if ((bid + G - 16) % G < NC1) FLAG_WAIT(QCTR(L, 8), 1024u);
            for (int u = (bid + G - 16) % G; u < NC1; u += G) {
                ++ndone;
                {
                    const int bh = u >> 4, e0 = (u & 15) * 256 + t, d = e0 >> 6;
                    float* Up = Ub + (size_t)bh * 128 * 4096 + e0;
                    const float* ap = aend + (size_t)bh * 128 * 64 + d;
                    float S = 0.f;
                    for (int c0 = 0; c0 < 128; c0 += 8) {
                        float uu[8], aa[8];
#pragma unroll
                        for (int k = 0; k < 8; ++k) { uu[k] = Up[(size_t)(c0 + k) * 4096]; aa[k] = ap[(c0 + k) * 64]; }
#pragma unroll
                        for (int k = 0; k < 8; ++k) { Up[(size_t)(c0 + k) * 4096] = S; S = aa[k] * S + uu[k]; }
                    }
                }
            }
            XCD_ARRIVE(L, 3, ndone, (void)xb_add(QCTR(L, 5), tot_ & 0xffffffu));
        }
        { PHASE_BEGIN_L
            FLAG_WAIT(QCTR(L, 6), 256u);
            unsigned* qc = QCTR(L, 1);
            for (;;) {
                int v; Q_NEXT(qc, v);
                if (v >= 512) break;
                {
                    const int qt = 63 - (v >> 3), b = (v >> 2) & 1, h = v & 3, t0 = qt * 128, own = t0 >> 8;
                    float* qs = (float*)smem;
                    float* km = qs + 64 * 65;
                    float* gl = km + 32 * 64;
                    unsigned* selm = (unsigned*)(smem + 65536);
                    for (int j = 0; j < 2; ++j) {
                        {
                            const int qi = t >> 2, dp = (t & 3) * 16;
                            const bf16_t* src = zb + ((size_t)b * 8192 + t0 + j * 64 + qi) * ZLD + Z_MQ + h * 64 + dp;
                            const uint4 a0 = *(const uint4*)src, a1 = *(const uint4*)(src + 8);
                            float* dq = qs + qi * 65 + dp;
                            dq[0] = bflo(a0.x); dq[1] = bfhi(a0.x); dq[2] = bflo(a0.y); dq[3] = bfhi(a0.y); dq[4] = bflo(a0.z); dq[5] = bfhi(a0.z); dq[6] = bflo(a0.w); dq[7] = bfhi(a0.w);
                            dq[8] = bflo(a1.x); dq[9] = bfhi(a1.x); dq[10] = bflo(a1.y); dq[11] = bfhi(a1.y); dq[12] = bflo(a1.z); dq[13] = bfhi(a1.z); dq[14] = bflo(a1.w); dq[15] = bfhi(a1.w);
                            if (j == 0) for (int i = t; i < own * 64; i += 256) km[i] = kmean[(size_t)(b * 4 + h) * 2048 + i];
                        }
                        __syncthreads();
                        {
                            const int qi = t & 63, ngp = t >> 6;
                            for (int n = ngp * 8; n < ngp * 8 + 8; ++n) {
                                if (n < own) { float s = 0.f;
#pragma unroll 16
                                    for (int d = 0; d < 64; ++d) s += qs[qi * 65 + d] * km[n * 64 + d];
                                    gl[qi * 33 + n] = s; }
                            }
                        }
                        __syncthreads();
                        if (t < 64) {
                            float v1 = NEG_INF, v2 = NEG_INF, v3 = NEG_INF; int i1 = -1, i2 = -1, i3 = -1;
                            for (int n = 0; n < own; ++n) {
                                const float s = gl[t * 33 + n];
                                if (s > v1) { v3 = v2; i3 = i2; v2 = v1; i2 = i1; v1 = s; i1 = n; }
                                else if (s > v2) { v3 = v2; i3 = i2; v2 = s; i2 = n; }
                                else if (s > v3) { v3 = s; i3 = n; }
                            }
                            unsigned m = 0u; if (i1 >= 0) m |= 1u << i1; if (i2 >= 0) m |= 1u << i2; if (i3 >= 0) m |= 1u << i3;
                            selm[j * 64 + t] = m;
                            unsigned um = m;
#pragma unroll
                            for (int off = 32; off >= 1; off >>= 1) um |= __shfl_xor(um, off);
                            if (t == 0) selm[128 + j] = um;
                        }
                        __syncthreads();
                    }
                    {
                        const int fr = lane & 15, g = lane >> 4, qpos0 = t0 + wid * 16 + fr, qpos1 = qpos0 + 64;
                        const unsigned mysel0 = selm[wid * 16 + fr], mysel1 = selm[64 + wid * 16 + fr], um = (unsigned)__builtin_amdgcn_readfirstlane((int)(selm[128] | selm[129]));
                        const bf16_t* qp = zb + ((size_t)b * 8192 + qpos0) * ZLD + Z_MQ + h * 64;
                        bf16x8 q0[2], q1[2]; q0[0] = *(const bf16x8*)(qp + g * 8); q0[1] = *(const bf16x8*)(qp + 32 + g * 8);
                        q1[0] = *(const bf16x8*)(qp + (size_t)64 * ZLD + g * 8); q1[1] = *(const bf16x8*)(qp + (size_t)64 * ZLD + 32 + g * 8);
                        AttnState st0, st1; attn_init(st0); attn_init(st1);
                        const int kd0 = 2 * qt, ktmax = 2 * qt + 1;
                        attn_run_g2(t, st0, st1, smem, zb + (size_t)b * 8192 * ZLD + Z_MK + h * 64, ZLD, vtm + (size_t)(b * 4 + h) * 64 * 8192, 8192, q0, q1, fr, g,
                            [&](int kt) { for (int k = kt + 1; k <= ktmax; ++k) { const int blk = k >> 2; if (blk == own || ((um >> blk) & 1u)) return k; } return -1; },
                            [&](int kt, bool& ok0, bool& chk0, bool& ok1, bool& chk1) { const int blk = kt >> 2; const bool past = blk < own;
                                ok0 = past ? (((mysel0 >> blk) & 1u) != 0u) : (kt <= kd0); ok1 = past ? (((mysel1 >> blk) & 1u) != 0u) : true; chk0 = (kt == kd0); chk1 = (kt == ktmax); },
                            [&](int kt, int kl) { return kt * 64 + kl <= qpos0; },
                            [&](int kt, int kl) { return kt * 64 + kl <= qpos1; });
                        const float inv0 = 1.f / st0.l, inv1 = 1.f / st1.l;
                        bf16_t* dst = ocat + ((size_t)b * 8192 + qpos0) * 1024 + h * 64;
#pragma unroll
                        for (int mi = 0; mi < 4; ++mi) { uint2 o; o.x = pack2(st0.o[mi][0] * inv0, st0.o[mi][1] * inv0); o.y = pack2(st0.o[mi][2] * inv0, st0.o[mi][3] * inv0);
                            *(uint2*)(dst + mi * 16 + 4 * g) = o; }
#pragma unroll
                        for (int mi = 0; mi < 4; ++mi) { uint2 o; o.x = pack2(st1.o[mi][0] * inv1, st1.o[mi][1] * inv1); o.y = pack2(st1.o[mi][2] * inv1, st1.o[mi][3] * inv1);
                            *(uint2*)(dst + (size_t)64 * 1024 + mi * 16 + 4 * g) = o; }
                    }
                    __syncthreads();
                }
            }
        }
        { PHASE_BEGIN_L
            FLAG_WAIT(QCTR(L, 4), 16u);
            unsigned* qc = QCTR(L, 2);
            for (;;) {
                int v; Q_NEXT(qc, v);
                if (v >= 1024) break;
                {
                    const int b = v & 1, qt = 511 - (v >> 1), t0 = qt * 16;
                    const int fr = lane & 15, g = lane >> 4, hd = wid, qpos = t0 + fr;
                    const size_t tok = (size_t)b * 8192 + qpos;
                    unsigned char* sK = smem; unsigned char* sV = smem + 8192;
                    float* impw = (float*)(smem + 16384);
                    float* scoreL = (float*)(smem + 16384 + 32768);
                    unsigned char* selb = smem + 65536 + 512;
                    unsigned* usel = (unsigned*)(selb + 256);
                    f32x4 outacc[4];
#pragma unroll
                    for (int mi = 0; mi < 4; ++mi) outacc[mi] = (f32x4){0.f, 0.f, 0.f, 0.f};
                    const bf16_t* gp = zb + tok * ZLD + Z_GATE + hd * 3;
                    const float g0 = sigmoidf_(bf2f(gp[0])), g1 = sigmoidf_(bf2f(gp[1])), g2 = sigmoidf_(bf2f(gp[2]));
                    {
                        const bf16_t* qp = zb + tok * ZLD + Z_NQ + hd * 64;
                        bf16x8 q[2]; q[0] = *(const bf16x8*)(qp + g * 8); q[1] = *(const bf16x8*)(qp + 32 + g * 8);
                        const int ktc = (t0 + 15 >= 31) ? (((t0 + 15 - 31) >> 4) >> 6) : -1;
                        const bf16_t* kb = kcb + (size_t)b * 512 * 64; const bf16_t* vb = vct + (size_t)b * 64 * 512;
                        const FragBase fb = frag_base(fr, g);
                        float mrun = NEG_INF, lrun = 0.f;
                        uint4 pk0 = make_uint4(0u, 0u, 0u, 0u), pk1 = pk0, pv0 = pk0, pv1 = pk0;
                        if (ktc >= 0) tile_ld(t, kb, 64, pk0, pk1);
                        for (int kt = 0; kt <= ktc; ++kt) {
                            tile_st(t, sK, pk0, pk1);
                            __syncthreads();
                            if (kt + 1 <= ktc) tile_ld(t, kb + (size_t)(kt + 1) * 64 * 64, 64, pk0, pk1);
                            f32x4 s[4]; qk_tile(s, sK, q, fb);
                            float mx = NEG_INF;
#pragma unroll
                            for (int ni = 0; ni < 4; ++ni)
#pragma unroll
                                for (int r = 0; r < 4; ++r) { const int n = kt * 64 + KEY_OF(ni, g, r); if (16 * n + 31 > qpos) s[ni][r] = NEG_INF; mx = fmaxf(mx, s[ni][r]); }
                            mx = xr_max(mx);
                            const float mnew = fmaxf(mrun, mx), muse = (mnew == NEG_INF) ? 0.f : mnew;
                            float ps = 0.f;
#pragma unroll
                            for (int ni = 0; ni < 4; ++ni)
#pragma unroll
                                for (int r = 0; r < 4; ++r) ps += EXP2(s[ni][r] - muse);
                            ps = xr_sum(ps);
                            lrun = lrun * EXP2(mrun - muse) + ps; mrun = mnew;
                            __syncthreads();
                        }
                        const float muse = (mrun == NEG_INF) ? 0.f : mrun, invl = (lrun > 0.f) ? 1.f / lrun : 0.f;
                        f32x4 oc[4], accN = (f32x4){0.f, 0.f, 0.f, 0.f};
#pragma unroll
                        for (int mi = 0; mi < 4; ++mi) oc[mi] = (f32x4){0.f, 0.f, 0.f, 0.f};
                        float* impr = impw + (hd * 16 + fr) * 128 + 4 * g;
                        if (ktc >= 0) { tile_ld(t, kb, 64, pk0, pk1); tile_ld(t, vb, 512, pv0, pv1); }
                        for (int kt = 0; kt <= ktc; ++kt) {
                            tile_st(t, sK, pk0, pk1); tile_st(t, sV, pv0, pv1);
                            __syncthreads();
                            if (kt + 1 <= ktc) { tile_ld(t, kb + (size_t)(kt + 1) * 64 * 64, 64, pk0, pk1); tile_ld(t, vb + (kt + 1) * 64, 512, pv0, pv1); }
                            f32x4 s[4]; qk_tile(s, sK, q, fb);
#pragma unroll
                            for (int ni = 0; ni < 4; ++ni)
#pragma unroll
                                for (int r = 0; r < 4; ++r) { const int n = kt * 64 + KEY_OF(ni, g, r); s[ni][r] = (16 * n + 31 <= qpos) ? EXP2(s[ni][r] - muse) * invl : 0.f; }
                            bf16x8 pf[2]; p_pack(pf, s);
                            pv_tile(oc, sV, pf, fb);
                            f32x4 accC = accN; accN = (f32x4){0.f, 0.f, 0.f, 0.f};
#pragma unroll
                            for (int dm = 0; dm < 2; ++dm) {
                                const int j = 16 * (kt + dm) + fr;
#pragma unroll
                                for (int kk = 0; kk < 2; ++kk) {
                                    bf16x8 of;
#pragma unroll
                                    for (int jj = 0; jj < 8; ++jj) {
                                        const int n = 64 * kt + 32 * kk + 8 * g + jj;
                                        of[jj] = (n >= 4 * j - 1 && n <= 4 * j + 3) ? (short)0x3F80 : (short)0;
                                    }
                                    if (dm == 0) accC = __builtin_amdgcn_mfma_f32_16x16x32_bf16(of, pf[kk], accC, 0, 0, 0);
                                    else accN = __builtin_amdgcn_mfma_f32_16x16x32_bf16(of, pf[kk], accN, 0, 0, 0);
                                }
                            }
                            *(float4*)(impr + 16 * kt) = make_float4(accC[0], accC[1], accC[2], accC[3]);
                            __syncthreads();
                        }
#pragma unroll
                        for (int mi = 0; mi < 8; ++mi) {
                            if (mi > ktc) { const float sc_ = (mi == ktc + 1) ? 1.f : 0.f; *(float4*)(impr + 16 * mi) = make_float4(accN[0] * sc_, accN[1] * sc_, accN[2] * sc_, accN[3] * sc_); }
                        }
#pragma unroll
                        for (int mi = 0; mi < 4; ++mi) outacc[mi] += oc[mi] * g0;
                    }
                    __syncthreads();
                    {
                        const int qi = t >> 4, jg = t & 15, qp2 = t0 + qi, cur = qp2 >> 6;
                        float sc[8];
#pragma unroll
                        for (int i = 0; i < 8; ++i) {
                            const int j = jg * 8 + i;
                            float s = impw[(0 * 16 + qi) * 128 + j] + impw[(1 * 16 + qi) * 128 + j] + impw[(2 * 16 + qi) * 128 + j] + impw[(3 * 16 + qi) * 128 + j];
                            const bool forced = (j == 0) || (j == cur) || (j == cur - 1);
                            const bool valid = (j <= cur);
                            s = valid ? (forced ? 1e9f : s) : NEG_INF;
                            sc[i] = s; scoreL[qi * 129 + j] = s;
                        }
                        __syncthreads();
                        int rank[8];
#pragma unroll
                        for (int i = 0; i < 8; ++i) rank[i] = 0;
                        for (int j2 = 0; j2 < 128; ++j2) {
                            const float s2 = scoreL[qi * 129 + j2];
#pragma unroll
                            for (int i = 0; i < 8; ++i) { const int j = jg * 8 + i; rank[i] += (s2 > sc[i] || (s2 == sc[i] && j2 < j)) ? 1 : 0; }
                        }
                        unsigned byte = 0u;
#pragma unroll
                        for (int i = 0; i < 8; ++i) if (rank[i] < 16 && (jg * 8 + i) <= cur) byte |= 1u << i;
                        selb[qi * 16 + jg] = (unsigned char)byte;
                        __syncthreads();
                        if (t < 4) { unsigned um = 0u; for (int q2 = 0; q2 < 16; ++q2) um |= ((const unsigned*)selb)[q2 * 4 + t]; usel[t] = um; }
                        __syncthreads();
                    }
                    {
                        const bf16_t* qp = qrot + tok * 256 + hd * 64;
                        bf16x8 q[2]; q[0] = *(const bf16x8*)(qp + g * 8); q[1] = *(const bf16x8*)(qp + 32 + g * 8);
                        const unsigned* myselp = (const unsigned*)selb + fr * 4;
                        const unsigned ms0 = myselp[0], ms1 = myselp[1], ms2 = myselp[2], ms3 = myselp[3];
                        const unsigned us0 = (unsigned)__builtin_amdgcn_readfirstlane((int)usel[0]), us1 = (unsigned)__builtin_amdgcn_readfirstlane((int)usel[1]),
                                       us2 = (unsigned)__builtin_amdgcn_readfirstlane((int)usel[2]), us3 = (unsigned)__builtin_amdgcn_readfirstlane((int)usel[3]);
                        const int ktmax = (t0 + 15) >> 6;
                        {
                            AttnState st; attn_init(st);
                            attn_run(t, st, smem, zb + (size_t)b * 8192 * ZLD + Z_KS, ZLD, vts + (size_t)b * 64 * 8192, 8192, q, fr, g,
                                [&](int kt) { for (int k = kt + 1; k <= ktmax; ++k) { const int wq = k >> 5; const unsigned uw = (wq == 0) ? us0 : (wq == 1) ? us1 : (wq == 2) ? us2 : us3;
                                                                  if ((uw >> (k & 31)) & 1u) return k; } return -1; },
                                [&](int kt, bool& ok, bool& chk) { const int wq = kt >> 5; const unsigned mw = (wq == 0) ? ms0 : (wq == 1) ? ms1 : (wq == 2) ? ms2 : ms3;
                                                                   ok = ((mw >> (kt & 31)) & 1u) != 0u; chk = (kt == ktmax); },
                                [&](int kt, int kl) { return kt * 64 + kl <= qpos; });
                            const float inv = (st.l > 0.f) ? 1.f / st.l : 0.f;
#pragma unroll
                            for (int mi = 0; mi < 4; ++mi) outacc[mi] += st.o[mi] * (g1 * inv);
                        }
                        {
                            AttnState st; attn_init(st);
                            const int ktmin = (t0 >= 511) ? ((t0 - 511) >> 6) : 0;
                            attn_run(t, st, smem, zb + (size_t)b * 8192 * ZLD + Z_KW, ZLD, vtw + (size_t)b * 64 * 8192, 8192, q, fr, g,
                                [&](int kt) { const int k = (kt < 0) ? ktmin : kt + 1; return (k <= ktmax) ? k : -1; },
                                [&](int kt, bool& ok, bool& chk) { ok = true; chk = !((kt * 64 > t0 + 15 - 512) && (kt * 64 + 63 <= t0)); },
                                [&](int kt, int kl) { const int key = kt * 64 + kl; return (key <= qpos) && (key > qpos - 512); });
                            const float inv = (st.l > 0.f) ? 1.f / st.l : 0.f;
#pragma unroll
                            for (int mi = 0; mi < 4; ++mi) outacc[mi] += st.o[mi] * (g2 * inv);
                        }
                    }
                    bf16_t* dst = ocat + tok * 1024 + 256 + hd * 64;
#pragma unroll
                    for (int mi = 0; mi < 4; ++mi) { uint2 o; o.x = pack2(outacc[mi][0], outacc[mi][1]); o.y = pack2(outacc[mi][2], outacc[mi][3]);
                        *(uint2*)(dst + mi * 16 + 4 * g) = o; }
                    __syncthreads();
                }
            }
        }
        { PHASE_BEGIN_L
            FLAG_WAIT(QCTR(L, 5), 128u);
            unsigned* qc = QCTR(L, 3);
            for (;;) {
                int u; Q_NEXT(qc, u);
                if (u >= 1024) break;
                const int b = u >> 9, h = (u >> 7) & 3, c = u & 127;
                const size_t tok0 = (size_t)b * 8192 + c * 64;
                float* qeT = (float*)smem;
                float* keT = qeT + 64 * 65;
                float* at = keT + 64 * 65;
                float* Sl = at + 64 * 65;
                for (int i = t; i < 4096; i += 256) {
                    const int r = i >> 6, d = i & 63;
                    const float bb = bcum[(tok0 + r) * 256 + h * 64 + d];
                    qeT[d * 65 + r] = bf2f(zb[(tok0 + r) * ZLD + Z_GQ + h * 64 + d]) * __expf(bb);
                    keT[d * 65 + r] = bf2f(zb[(tok0 + r) * ZLD + Z_GK + h * 64 + d]) * __expf(-bb);
                    Sl[i] = Ub[((size_t)(b * 4 + h) * 128 + c) * 4096 + i];
                }
                __syncthreads();
                const int fr = lane & 15, g = lane >> 4, i0 = 16 * wid;
                {
                    f32x4 aa[4];
#pragma unroll
                    for (int n = 0; n < 4; ++n) aa[n] = (f32x4){0.f, 0.f, 0.f, 0.f};
                    for (int d0 = 0; d0 < 64; d0 += 4) {
                        const float a = qeT[(d0 + g) * 65 + i0 + fr];
#pragma unroll
                        for (int n = 0; n < 4; ++n) aa[n] = __builtin_amdgcn_mfma_f32_16x16x4f32(a, keT[(d0 + g) * 65 + 16 * n + fr], aa[n], 0, 0, 0);
                    }
#pragma unroll
                    for (int n = 0; n < 4; ++n)
#pragma unroll
                        for (int r = 0; r < 4; ++r) { const int i = i0 + 4 * g + r, j = 16 * n + fr; at[i * 65 + j] = (j <= i) ? aa[n][r] : 0.f; }
                }
                __syncthreads();
                for (int i = t; i < 4096; i += 256) { const int r = i >> 6, d = i & 63; keT[i] = bf2f(zb[(tok0 + r) * ZLD + Z_GV + h * 64 + d]); }
                __syncthreads();
                {
                    f32x4 oa[4];
#pragma unroll
                    for (int n = 0; n < 4; ++n) oa[n] = (f32x4){0.f, 0.f, 0.f, 0.f};
                    for (int j0 = 0; j0 < i0 + 16; j0 += 4) {
                        const float a = at[(i0 + fr) * 65 + j0 + g];
#pragma unroll
                        for (int n = 0; n < 4; ++n) oa[n] = __builtin_amdgcn_mfma_f32_16x16x4f32(a, keT[(j0 + g) * 64 + 16 * n + fr], oa[n], 0, 0, 0);
                    }
                    for (int d0 = 0; d0 < 64; d0 += 4) {
                        const float a = qeT[(d0 + g) * 65 + i0 + fr];
#pragma unroll
                        for (int n = 0; n < 4; ++n) oa[n] = __builtin_amdgcn_mfma_f32_16x16x4f32(a, Sl[(d0 + g) * 64 + 16 * n + fr], oa[n], 0, 0, 0);
                    }
                    float gnv[4];
#pragma unroll
                    for (int n = 0; n < 4; ++n) gnv[n] = p.gla_norm[(size_t)L * 64 + 16 * n + fr];
#pragma unroll
                    for (int r = 0; r < 4; ++r) {
                        const int i = i0 + 4 * g + r;
                        float ss = oa[0][r] * oa[0][r] + oa[1][r] * oa[1][r] + oa[2][r] * oa[2][r] + oa[3][r] * oa[3][r];
                        ss += __shfl_xor(ss, 1); ss += __shfl_xor(ss, 2); ss += __shfl_xor(ss, 4); ss += __shfl_xor(ss, 8);
                        const float rs = rsqrtf(ss * (1.f / 64.f) + LN_EPS);
#pragma unroll
                        for (int n = 0; n < 4; ++n) {
                            const float gv = bf2f(zb[(tok0 + i) * ZLD + Z_GG + h * 64 + 16 * n + fr]);
                            ocat[(tok0 + i) * 1024 + 768 + h * 64 + 16 * n + fr] = f2bf(oa[n][r] * rs * gnv[n] * siluf_(gv));
                        }
                    }
                }
                __syncthreads();
            }
        }
        GRID_BARRIER();

        { PHASE_BEGIN_L
            const bf16_t* W = WTL(L) + WT_OUT;
            for (int u = bid; u < 64 * 8; u += G) {
                const int mt = u >> 3, nt = u & 7, row0 = mt * 256, n0 = nt * 128;
                gemm_dma256(smem, t, 32, ocat + (size_t)row0 * 1024, [&](int r) { return (unsigned)(r * 1024); },
                    W + (size_t)n0 * 1024, [&](int r) { return (unsigned)(r * 1024); },
                    [&](f32x4 (&acc)[4][8], int wr, int fr, int g) {
#pragma unroll
                        for (int m = 0; m < 4; ++m) {
                            const int tok = row0 + wr * 64 + m * 16 + fr, b = tok >> 13;
#pragma unroll
                            for (int n = 0; n < 8; ++n) {
                                const int col = n0 + n * 16 + 4 * g;
                                float4 xv;
                                if (L == 0) xv = *(const float4*)(p.x + (size_t)tok * 1024 + col);
                                else { const uint2 xr = *(const uint2*)(xBh + (size_t)tok * 1024 + col); xv = make_float4(bflo(xr.x), bfhi(xr.x), bflo(xr.y), bfhi(xr.y)); }
                                const float4 gm = *(const float4*)(modL + b * 6144 + 2048 + col);
                                uint2 o; o.x = pack2(ALPHA * xv.x + gm.x * acc[m][n][0], ALPHA * xv.y + gm.y * acc[m][n][1]);
                                o.y = pack2(ALPHA * xv.z + gm.z * acc[m][n][2], ALPHA * xv.w + gm.w * acc[m][n][3]);
                                *(uint2*)(r1h + (size_t)tok * 1024 + col) = o;
                            }
                        }
                    });
            }
        }
        GRID_BARRIER();

        { PHASE_BEGIN_L
            const float* lg = p.ln_g + ((size_t)L * 2 + 0) * 1024, *lb = p.ln_b + ((size_t)L * 2 + 0) * 1024;
            const bf16_t* Wr = WTL(L) + WT_R;
            const float* rb = p.router_bias + (size_t)L * 256;
            unsigned* cnt = cntb + L * 256 * CSTR;
            for (int u = bid; u < 512; u += G) {
                const int row0 = u * 32;
                for (int r = 0; r < 8; ++r) {
                    const int tok = row0 + wid * 8 + r, b = tok >> 13;
                    float4 v[4]; float s = 0.f;
#pragma unroll
                    for (int i = 0; i < 4; ++i) { const uint2 rr = *(const uint2*)(r1h + (size_t)tok * 1024 + i * 256 + lane * 4);
                        v[i] = make_float4(bflo(rr.x), bfhi(rr.x), bflo(rr.y), bfhi(rr.y)); s += v[i].x + v[i].y + v[i].z + v[i].w; }
                    s = wave_sum(s);
                    const float mu = s * (1.f / 1024.f);
                    float q = 0.f;
#pragma unroll
                    for (int i = 0; i < 4; ++i) { const float a = v[i].x - mu, bq = v[i].y - mu, c = v[i].z - mu, d = v[i].w - mu; q += a * a + bq * bq + c * c + d * d; }
                    q = wave_sum(q);
                    const float rs = rsqrtf(q * (1.f / 1024.f) + LN_EPS);
#pragma unroll
                    for (int i = 0; i < 4; ++i) {
                        const int d = i * 256 + lane * 4;
                        const float4 gg = *(const float4*)(lg + d), bb = *(const float4*)(lb + d);
                        const float4 sh = *(const float4*)(modL + b * 6144 + 3072 + d), sc = *(const float4*)(modL + b * 6144 + 4096 + d);
                        float4 o; o.x = (v[i].x - mu) * rs * gg.x + bb.x; o.y = (v[i].y - mu) * rs * gg.y + bb.y; o.z = (v[i].z - mu) * rs * gg.z + bb.z; o.w = (v[i].w - mu) * rs * gg.w + bb.w;
                        { uint2 xo2; xo2.x = pack2(o.x, o.y); xo2.y = pack2(o.z, o.w); *(uint2*)(xAh + (size_t)tok * 1024 + d) = xo2; }
                        uint2 hh; hh.x = pack2(o.x * (1.f + sc.x) + sh.x, o.y * (1.f + sc.y) + sh.y); hh.y = pack2(o.z * (1.f + sc.z) + sh.z, o.w * (1.f + sc.w) + sh.w);
                        *(uint2*)(hbuf + (size_t)tok * 1024 + d) = hh;
                    }
                }
                __syncthreads();
                for (int nt = 0; nt < 2; ++nt) {
                    const int n0 = nt * 128;
                    gemm_dma<32, 2>(smem, t, 16, hbuf + (size_t)row0 * 1024, [&](int r) { return (unsigned)(r * 1024); }, 64,
                        Wr + (size_t)n0 * 1024, [&](int r) { return (unsigned)(r * 1024); },
                        [&](f32x4 (&acc)[1][4], int wr, int wc, int fr, int g) {
#pragma unroll
                            for (int n = 0; n < 4; ++n) {
                                const int tok = row0 + wr * 16 + fr, col = n0 + wc * 64 + n * 16 + 4 * g;
                                *(float4*)(logit + (size_t)tok * 256 + col) = make_float4(acc[0][n][0], acc[0][n][1], acc[0][n][2], acc[0][n][3]);
                            }
                        });
                }
                __syncthreads();
                for (int r = 0; r < 8; ++r) {
                    const int tok = row0 + wid * 8 + r;
                    const float4 lv = *(const float4*)(logit + (size_t)tok * 256 + lane * 4);
                    const float4 bv = *(const float4*)(rb + lane * 4);
                    const float s[4] = {sigmoidf_(lv.x), sigmoidf_(lv.y), sigmoidf_(lv.z), sigmoidf_(lv.w)};
                    const float ss[4] = {s[0] + bv.x, s[1] + bv.y, s[2] + bv.z, s[3] + bv.w};
                    float m1 = NEG_INF, m2 = NEG_INF;
#pragma unroll
                    for (int i = 0; i < 4; ++i) { if (ss[i] > m1) { m2 = m1; m1 = ss[i]; } else if (ss[i] > m2) m2 = ss[i]; }
                    { const float o1 = dppf<0xB1>(m1), o2 = dppf<0xB1>(m2); const float n1 = fmaxf(m1, o1), n2 = fmaxf(fminf(m1, o1), fmaxf(m2, o2)); m1 = n1; m2 = n2; }
                    { const float o1 = dppf<0x4E>(m1), o2 = dppf<0x4E>(m2); const float n1 = fmaxf(m1, o1), n2 = fmaxf(fminf(m1, o1), fmaxf(m2, o2)); m1 = n1; m2 = n2; }
                    { const float o1 = dppf<0x141>(m1), o2 = dppf<0x141>(m2); const float n1 = fmaxf(m1, o1), n2 = fmaxf(fminf(m1, o1), fmaxf(m2, o2)); m1 = n1; m2 = n2; }
                    const float gs = m1 + m2; const int gi = lane >> 3;
                    int rank = 0;
#pragma unroll
                    for (int gj = 0; gj < 8; ++gj) { const float og = __uint_as_float(__builtin_amdgcn_readlane(__float_as_uint(gs), gj * 8)); rank += (og > gs || (og == gs && gj < gi)) ? 1 : 0; }
                    const bool gsel = rank < 4;
                    u64_t key[4];
#pragma unroll
                    for (int i = 0; i < 4; ++i) { unsigned ub = __float_as_uint(ss[i]); ub ^= (ub >> 31) ? 0xFFFFFFFFu : 0x80000000u;
                        key[i] = gsel ? (((u64_t)ub << 32) | (0xFFFFFFFFu - (unsigned)(lane * 4 + i))) : 0ull; }
                    int my_e = 0; float my_s = 0.f;
                    for (int k = 0; k < 8; ++k) {
                        u64_t best = max64(max64(key[0], key[1]), max64(key[2], key[3]));
                        best = wave_max64(best);
                        const int bi = __builtin_amdgcn_readfirstlane((int)(0xFFFFFFFFu - (unsigned)best));
                        const int owner = bi >> 2, sub = bi & 3;
                        const float cand = (sub == 0) ? s[0] : (sub == 1) ? s[1] : (sub == 2) ? s[2] : s[3];
                        const float sval = __uint_as_float(__builtin_amdgcn_readlane(__float_as_uint(cand), owner));
#pragma unroll
                        for (int i = 0; i < 4; ++i) if (key[i] == best) key[i] = 0ull;
                        if (lane == k) { my_e = bi; my_s = sval; }
                    }
                    float tot = (lane < 8) ? my_s : 0.f;
                    tot += dppf<0xB1>(tot); tot += dppf<0x4E>(tot); tot += dppf<0x141>(tot);
                    if (lane < 8) {
                        const float w = my_s / tot * 2.5f;
                        ewb[(size_t)tok * 8 + lane] = w;
                        const unsigned pos = atomicAdd(&cnt[my_e * CSTR], 1u);
                        listb[(size_t)my_e * 16384 + pos] = tok * 8 + lane;
                    }
                }
                __syncthreads();
            }
        }
        GRID_BARRIER();

        int* tpre = (int*)(smem + 65536);
        int* rpre = tpre + 260;
        int* txp = tpre + 520;
        int* tx2 = txp + 264;
        { PHASE_BEGIN_L
            const unsigned* cnt = cntb + L * 256 * CSTR;
            int* cl = tpre;
            { int n = (int)cnt[t * CSTR]; n = n < 0 ? 0 : (n > 16384 ? 16384 : n); cl[t] = n; }
            __syncthreads();
            if (t == 0) { int ra = 0; for (int e = 0; e < 256; ++e) { rpre[e] = ra; ra += cl[e]; } rpre[256] = ra; }
            if (t >= 64 && t < 72) { const int x = t - 64; int ta = 0, tb = 0;
                for (int i = 0; i < 32; ++i) { txp[x * 33 + i] = ta; tx2[x * 33 + i] = tb; const int n = cl[x + 8 * i]; ta += (n + 127) >> 7; tb += (n + 255) >> 8; }
                txp[x * 33 + 32] = ta; tx2[x * 33 + 32] = tb; }
            __syncthreads();
        }
        { PHASE_BEGIN_L
            const int xg = bid & 7, xslot = bid >> 3, nslot = G >> 3;
            const int nXu = __builtin_amdgcn_readfirstlane(tx2[xg * 33 + 32] * 4);
            for (int w = xslot; w < nXu + 32; w += nslot) {
                int e, mt, ne, hoff, sub;
                if (w < nXu) { int lo = 0, hi = 31; while (lo < hi) { const int mid = (lo + hi + 1) >> 1; if (tx2[xg * 33 + mid] * 4 <= w) lo = mid; else hi = mid - 1; }
                    const int nte = tx2[xg * 33 + lo + 1] - tx2[xg * 33 + lo], li = w - tx2[xg * 33 + lo] * 4;
                    e = xg + 8 * lo; sub = li / nte; mt = li - sub * nte; ne = rpre[e + 1] - rpre[e]; hoff = rpre[e]; }
                else { const int w2 = w - nXu; e = 256; mt = xg * 8 + (w2 >> 2); sub = w2 & 3; ne = 16384; hoff = 131072; }
                e = __builtin_amdgcn_readfirstlane(e); mt = __builtin_amdgcn_readfirstlane(mt); ne = __builtin_amdgcn_readfirstlane(ne); hoff = __builtin_amdgcn_readfirstlane(hoff); sub = __builtin_amdgcn_readfirstlane(sub);
                const int j0 = sub * 64;
                const float* Wg = (e < 256) ? (p.exp_gate + ((size_t)L * 256 + e) * 262144) : (p.sh_gate + (size_t)L * 262144);
                const float* Wu = (e < 256) ? (p.exp_up + ((size_t)L * 256 + e) * 262144) : (p.sh_up + (size_t)L * 262144);
                const int* lst = listb + (size_t)e * 16384;
                gemm_fb256(smem, t, 32, hbuf,
                    [&](int r) { const int i = mt * 256 + r; if (i >= ne) return 0u;
                                 const int tok = (e < 256) ? (lst[i] >> 3) : i; return (unsigned)(tok * 1024); },
                    Wg + j0, Wu + j0, 256,
                    [&](f32x4 (&acc)[4][8], int wr, int fr, int g) {
#pragma unroll
                        for (int m = 0; m < 4; ++m) {
                            const int i = mt * 256 + wr * 64 + m * 16 + fr;
                            if (i < ne) {
#pragma unroll
                                for (int k2 = 0; k2 < 2; ++k2) {
                                    float hv[8];
#pragma unroll
                                    for (int r = 0; r < 4; ++r) { hv[r] = siluf_(acc[m][2 * k2][r]) * acc[m][2 * k2 + 4][r]; hv[4 + r] = siluf_(acc[m][2 * k2 + 1][r]) * acc[m][2 * k2 + 5][r]; }
                                    uint4 o; o.x = pack2(hv[0], hv[1]); o.y = pack2(hv[2], hv[3]); o.z = pack2(hv[4], hv[5]); o.w = pack2(hv[6], hv[7]);
                                    *(uint4*)(hid + (size_t)(hoff + i) * 256 + j0 + k2 * 32 + 8 * g) = o;
                                }
                            }
                        }
                    });
            }
        }
        GRID_BARRIER();
        { PHASE_BEGIN_L
            const int xg = bid & 7, xslot = bid >> 3, nslot = G >> 3;
            const int fr = lane & 15, g = lane >> 4;
            const int ng = (t & 7) + 8 * ((t >> 4) & 1), kg = ((t >> 3) & 1) + 2 * (t >> 5);
            const int prow = ((((ng >> 3) & 1) * 2 + (ng & 1)) * 16) + 4 * ((ng >> 1) & 3);
            for (int w = xslot; w < 16 + 256; w += nslot) {
                int e, ntile, mt0, mt1, ne, hoff;
                if (w < 16) { const int u2 = xg * 16 + w; e = 256; ntile = u2 & 7; mt0 = (u2 >> 3) * 8; mt1 = mt0 + 8; ne = 16384; hoff = 131072; }
                else { const int w3 = w - 16; e = xg + 8 * (w3 >> 3); ntile = w3 & 7; ne = __builtin_amdgcn_readfirstlane(rpre[e + 1] - rpre[e]); hoff = __builtin_amdgcn_readfirstlane(rpre[e]);
                       mt0 = 0; mt1 = (ne + 127) >> 7; }
                if (mt1 <= mt0) continue;
                const int n0 = ntile * 128;
                const float* Wd = ((e < 256) ? (p.exp_down + ((size_t)L * 256 + e) * 262144) : (p.sh_down + (size_t)L * 262144)) + n0;
                const int* lst = listb + (size_t)e * 16384;
#pragma unroll
                for (int kp = 0; kp < 2; ++kp) {
                    float4 bq[2][2][4];
#pragma unroll
                    for (int k2 = 0; k2 < 2; ++k2) { const float* p0 = Wd + (size_t)((kp * 2 + k2) * 64 + kg * 4) * 1024 + ng * 4;
#pragma unroll
                        for (int i = 0; i < 4; ++i) { bq[k2][0][i] = *(const float4*)(p0 + (size_t)i * 1024); bq[k2][1][i] = *(const float4*)(p0 + 64 + (size_t)i * 1024); } }
#pragma unroll
                    for (int k2 = 0; k2 < 2; ++k2) { unsigned char* sB = smem + (kp * 2 + k2) * 16384;
#pragma unroll
                        for (int pp = 0; pp < 2; ++pp) {
                            const float q0[4] = {bq[k2][pp][0].x, bq[k2][pp][0].y, bq[k2][pp][0].z, bq[k2][pp][0].w}, q1[4] = {bq[k2][pp][1].x, bq[k2][pp][1].y, bq[k2][pp][1].z, bq[k2][pp][1].w};
                            const float q2[4] = {bq[k2][pp][2].x, bq[k2][pp][2].y, bq[k2][pp][2].z, bq[k2][pp][2].w}, q3[4] = {bq[k2][pp][3].x, bq[k2][pp][3].y, bq[k2][pp][3].z, bq[k2][pp][3].w};
#pragma unroll
                            for (int i = 0; i < 4; ++i) { uint2 wv; wv.x = pack2(q0[i], q1[i]); wv.y = pack2(q2[i], q3[i]);
                                *(uint2*)(sB + swz(pp * 64 + prow + i, kg >> 1) + (kg & 1) * 8) = wv; }
                        } }
                }
                __syncthreads();
                for (int mt = mt0; mt < mt1; ++mt) {
                    int rowi[2], ent[2]; bf16_t* dstp[2]; float wgt[2];
                    bf16x8 afr[2][8];
#pragma unroll
                    for (int m = 0; m < 2; ++m) { rowi[m] = mt * 128 + wid * 32 + m * 16 + fr; ent[m] = (e < 256) ? lst[(rowi[m] < ne) ? rowi[m] : mt * 128] : rowi[m]; }
                    const bf16_t* ap0 = hid + (size_t)(hoff + ((rowi[0] < ne) ? rowi[0] : mt * 128)) * 256 + g * 8;
                    const bf16_t* ap1 = hid + (size_t)(hoff + ((rowi[1] < ne) ? rowi[1] : mt * 128)) * 256 + g * 8;
#pragma unroll
                    for (int ks = 0; ks < 8; ++ks) { afr[0][ks] = *(const bf16x8*)(ap0 + ks * 32); afr[1][ks] = *(const bf16x8*)(ap1 + ks * 32); }
#pragma unroll
                    for (int m = 0; m < 2; ++m) {
                        if (e < 256) { wgt[m] = ewb[ent[m]]; dstp[m] = (bf16_t*)(slot8 + (size_t)ent[m] * 1024); } else { wgt[m] = 1.f; dstp[m] = ysh + (size_t)rowi[m] * 1024; }
                    }
                    f32x4 acc[2][8];
#pragma unroll
                    for (int m = 0; m < 2; ++m)
#pragma unroll
                        for (int n = 0; n < 8; ++n) acc[m][n] = (f32x4){0.f, 0.f, 0.f, 0.f};
#pragma unroll
                    for (int kt = 0; kt < 4; ++kt) {
                        const unsigned char* sB = smem + kt * 16384;
#pragma unroll
                        for (int ks = 0; ks < 2; ++ks) {
#pragma unroll
                            for (int nh2 = 0; nh2 < 2; ++nh2) {
                                bf16x8 bfg[4];
#pragma unroll
                                for (int n = 0; n < 4; ++n) bfg[n] = *(const bf16x8*)(sB + swz((nh2 * 4 + n) * 16 + fr, ks * 4 + g));
#pragma unroll
                                for (int m = 0; m < 2; ++m)
#pragma unroll
                                    for (int n = 0; n < 4; ++n) acc[m][nh2 * 4 + n] = __builtin_amdgcn_mfma_f32_16x16x32_bf16(bfg[n], afr[m][2 * kt + ks], acc[m][nh2 * 4 + n], 0, 0, 0);
                                __builtin_amdgcn_sched_barrier(0);
                            }
                        }
                    }
#pragma unroll
                    for (int m = 0; m < 2; ++m) {
                        const float wsc = wgt[m];
                        if (e < 256) {
                            float am = 0.f;
#pragma unroll
                            for (int n = 0; n < 8; ++n) am = fmaxf(fmaxf(am, fmaxf(fabsf(acc[m][n][0]), fabsf(acc[m][n][1]))), fmaxf(fabsf(acc[m][n][2]), fabsf(acc[m][n][3])));
                            am = xr_max(am * wsc);
                            unsigned eb = (__float_as_uint(am) >> 23) & 255u; eb = eb < 8u ? 8u : eb;
                            const float qs = __uint_as_float((261u - eb) << 23) * wsc;
                            if (rowi[m] < ne) {
                                unsigned char* drow = (unsigned char*)dstp[m];
#pragma unroll
                                for (int hk = 0; hk < 4; ++hk) {
                                    int w0 = __builtin_amdgcn_cvt_pk_fp8_f32(acc[m][2 * hk][0] * qs, acc[m][2 * hk][1] * qs, 0, false);
                                    w0 = __builtin_amdgcn_cvt_pk_fp8_f32(acc[m][2 * hk][2] * qs, acc[m][2 * hk][3] * qs, w0, true);
                                    int w1 = __builtin_amdgcn_cvt_pk_fp8_f32(acc[m][2 * hk + 1][0] * qs, acc[m][2 * hk + 1][1] * qs, 0, false);
                                    w1 = __builtin_amdgcn_cvt_pk_fp8_f32(acc[m][2 * hk + 1][2] * qs, acc[m][2 * hk + 1][3] * qs, w1, true);
                                    uint2 o; o.x = (unsigned)w0; o.y = (unsigned)w1;
                                    *(uint2*)(drow + n0 + hk * 32 + 8 * g) = o;
                                }
                                if (g == 0) sscl[(size_t)ent[m] * 8 + ntile] = (unsigned char)eb;
                            }
                        } else if (rowi[m] < ne) {
#pragma unroll
                            for (int hk = 0; hk < 4; ++hk) {
                                uint4 o; o.x = pack2(acc[m][2 * hk][0] * wsc, acc[m][2 * hk][1] * wsc); o.y = pack2(acc[m][2 * hk][2] * wsc, acc[m][2 * hk][3] * wsc);
                                o.z = pack2(acc[m][2 * hk + 1][0] * wsc, acc[m][2 * hk + 1][1] * wsc); o.w = pack2(acc[m][2 * hk + 1][2] * wsc, acc[m][2 * hk + 1][3] * wsc);
                                *(uint4*)(dstp[m] + n0 + hk * 32 + 8 * g) = o;
                            }
                        }
                    }
                }
                __syncthreads();
            }
        }
        GRID_BARRIER();

        { PHASE_BEGIN_L
            const float* lg = p.ln_g + ((size_t)L * 2 + 1) * 1024, *lb = p.ln_b + ((size_t)L * 2 + 1) * 1024;
            const bool last = (L == NLAYER - 1);
            const float* modN = modb + (size_t)(L + 1) * 2 * 6144;
            for (int tok0 = (bid * 4 + wid) * 2; tok0 < NTOK; tok0 += G * 8) {
                float v[2][16]; float s[2] = {0.f, 0.f};
#pragma unroll
                for (int tt = 0; tt < 2; ++tt) {
                    const int tok = tok0 + tt, b = tok >> 13;
#pragma unroll
                    for (int i = 0; i < 4; ++i) {
                        const int d = i * 256 + lane * 4;
                        const uint2 xr = *(const uint2*)(xAh + (size_t)tok * 1024 + d);
                        const float4 xv = make_float4(bflo(xr.x), bfhi(xr.x), bflo(xr.y), bfhi(xr.y));
                        const float4 gf = *(const float4*)(modL + b * 6144 + 5120 + d);
                        const uint2 sy = *(const uint2*)(ysh + (size_t)tok * 1024 + d);
                        float y[4] = {bflo(sy.x), bfhi(sy.x), bflo(sy.y), bfhi(sy.y)};
                        unsigned sv[8]; uint2 sc8[8];
#pragma unroll
                        for (int k = 0; k < 8; ++k) { sv[k] = *(const unsigned*)(slot8 + ((size_t)tok * 8 + k) * 1024 + d); sc8[k] = *(const uint2*)(sscl + ((size_t)tok * 8 + k) * 8); }
                        const int ntl = i * 2 + (lane >> 5);
#pragma unroll
                        for (int k = 0; k < 8; ++k) {
                            const unsigned ew = (ntl < 4) ? sc8[k].x : sc8[k].y, eb = (ew >> ((ntl & 3) * 8)) & 255u;
                            const float inv = __uint_as_float((eb - 7u) << 23);
                            const auto f01 = __builtin_amdgcn_cvt_pk_f32_fp8((int)sv[k], false); const auto f23 = __builtin_amdgcn_cvt_pk_f32_fp8((int)sv[k], true);
                            y[0] += f01[0] * inv; y[1] += f01[1] * inv; y[2] += f23[0] * inv; y[3] += f23[1] * inv;
                        }
                        v[tt][i * 4 + 0] = ALPHA * xv.x + gf.x * y[0]; v[tt][i * 4 + 1] = ALPHA * xv.y + gf.y * y[1]; v[tt][i * 4 + 2] = ALPHA * xv.z + gf.z * y[2]; v[tt][i * 4 + 3] = ALPHA * xv.w + gf.w * y[3];
                        s[tt] += v[tt][i * 4] + v[tt][i * 4 + 1] + v[tt][i * 4 + 2] + v[tt][i * 4 + 3];
                    }
                }
#pragma unroll
                for (int tt = 0; tt < 2; ++tt) {
                    const int tok = tok0 + tt, b = tok >> 13;
                    const float mu = wave_sum(s[tt]) * (1.f / 1024.f);
                    float q = 0.f;
#pragma unroll
                    for (int i = 0; i < 16; ++i) { const float a = v[tt][i] - mu; q += a * a; }
                    q = wave_sum(q);
                    const float rs = rsqrtf(q * (1.f / 1024.f) + LN_EPS);
#pragma unroll
                    for (int i = 0; i < 4; ++i) {
                        const int d = i * 256 + lane * 4;
                        const float4 gg = *(const float4*)(lg + d), bb = *(const float4*)(lb + d);
                        float4 o; o.x = (v[tt][i * 4] - mu) * rs * gg.x + bb.x; o.y = (v[tt][i * 4 + 1] - mu) * rs * gg.y + bb.y; o.z = (v[tt][i * 4 + 2] - mu) * rs * gg.z + bb.z; o.w = (v[tt][i * 4 + 3] - mu) * rs * gg.w + bb.w;
                        if (last) *(float4*)(p.out + (size_t)tok * 1024 + d) = o;
                        else { uint2 xo2; xo2.x = pack2(o.x, o.y); xo2.y = pack2(o.z, o.w); *(uint2*)(xBh + (size_t)tok * 1024 + d) = xo2; }
                        if (!last) {
                            const float4 sh = *(const float4*)(modN + b * 6144 + d), sc = *(const float4*)(modN + b * 6144 + 1024 + d);
                            uint2 hh; hh.x = pack2(o.x * (1.f + sc.x) + sh.x, o.y * (1.f + sc.y) + sh.y); hh.y = pack2(o.z * (1.f + sc.z) + sh.z, o.w * (1.f + sc.w) + sh.w);
                            *(uint2*)(hbuf + (size_t)tok * 1024 + d) = hh;
                        }
                    }
                }
            }
        }
        if (Lrun + 1 < NLAYER) GRID_BARRIER();
    }
}

extern "C" void kernel_launch(void* const* d_in, const int* in_sizes, int n_in, void* d_out, int out_size, void* d_ws, size_t ws_size, hipStream_t stream) {
    (void)in_sizes; (void)n_in; (void)out_size;
    static int grid = 0;
    if (!grid) {
        int dev = 0, cus = 0, per_cu = 0;
        hipGetDevice(&dev);
        hipDeviceGetAttribute(&cus, hipDeviceAttributeMultiprocessorCount, dev);
        hipFuncSetAttribute((const void*)fwd_kernel, hipFuncAttributeMaxDynamicSharedMemorySize, SMEM_BYTES);
        hipOccupancyMaxActiveBlocksPerMultiprocessor(&per_cu, fwd_kernel, 256, SMEM_BYTES);
        if (per_cu < 1) per_cu = 1;
        grid = cus * (per_cu < 2 ? per_cu : 2);
    }
    if (ws_size < (size_t)WS_END) fprintf(stderr, "workspace too small: %zu < %llu\n", ws_size, (unsigned long long)WS_END);
    hipMemsetAsync(d_ws, 0, WS_ZERO_BYTES, stream);
    Params p{};
    const float** pp = (const float**)&p;
    for (int i = 0; i < 24; ++i) pp[i] = (const float*)d_in[i];
    p.out = (float*)d_out; p.ws = (unsigned char*)d_ws;
    hipLaunchKernelGGL(fwd_kernel, dim3(grid), dim3(256), SMEM_BYTES, stream, p);
}
```

```cpp
#include <hip/hip_runtime.h>
#include <stdint.h>
#include <stdio.h>

typedef unsigned short bf16_t;
typedef short bf16x8 __attribute__((ext_vector_type(8)));
typedef float f32x4 __attribute__((ext_vector_type(4)));
typedef __bf16 bf16x2_t __attribute__((ext_vector_type(2)));
typedef float f32x2_t __attribute__((ext_vector_type(2)));

#define XB_TMO      128
#define XB_XCNT(j)  (256  + 64 * (j))
#define XB_XSUB(j)  (1280 + 64 * (j))
#define XB_XGEN(j)  (2304 + 64 * (j))
#define XB_TOP      3328
#define XB_TOPGEN   3392
#define XCD_BAR_WORDS 3456
#define XB_SPIN_CAP (1u << 18)
#define LAS __attribute__((address_space(3)))

__device__ __forceinline__ unsigned xb_ld(unsigned* p)              { return __hip_atomic_load(p, __ATOMIC_RELAXED, __HIP_MEMORY_SCOPE_AGENT); }
__device__ __forceinline__ unsigned xb_add(unsigned* p, unsigned v) { return __hip_atomic_fetch_add(p, v, __ATOMIC_RELAXED, __HIP_MEMORY_SCOPE_AGENT); }
__device__ __forceinline__ unsigned xb_xcc_id() { return (unsigned)__builtin_amdgcn_s_getreg((3 << 11) | 20) & 0xFu; }
#define XB_SPIN(cond, bar) do { unsigned _sp = 0; while (cond) { __builtin_amdgcn_s_sleep(1); \
    if ((++_sp & 255u) == 0u) { if (xb_ld(&(bar)[XB_TMO])) break; if (_sp > XB_SPIN_CAP) { atomicAdd(&(bar)[XB_TMO], 1u); break; } } } } while (0)

struct XcdBarrier { unsigned* bar; unsigned x; volatile LAS unsigned* st; };

__device__ __forceinline__ XcdBarrier xcd_barrier_post(unsigned* bar, volatile LAS unsigned* st) {
    XcdBarrier b; b.bar = bar; b.x = xb_xcc_id(); b.st = st;
    if (threadIdx.x == 0) (void)xb_add(&bar[XB_XCNT(b.x)], 1u);
    return b;
}
__device__ __forceinline__ void xcd_barrier_complete(unsigned* bar, unsigned x, unsigned& nloc, unsigned& nx) {
    const unsigned G = gridDim.x * gridDim.y * gridDim.z;
    unsigned sum, cnt, mine, sp = 0u;
    for (;;) {
        sum = 0u; cnt = 0u; mine = 0u;
#pragma unroll
        for (unsigned j = 0; j < 16; ++j) { const unsigned c = xb_ld(&bar[XB_XCNT(j)]); sum += c; cnt += (c > 0u) ? 1u : 0u; mine = (j == x) ? c : mine; }
        if (sum == G) break;
        __builtin_amdgcn_s_sleep(1);
        if ((++sp & 255u) == 0u) { if (xb_ld(&bar[XB_TMO])) break; if (sp > XB_SPIN_CAP) { atomicAdd(&bar[XB_TMO], 1u); break; } }
    }
    nloc = mine > 0u ? mine : 1u; nx = cnt > 0u ? cnt : 1u;
}
__device__ __forceinline__ void xcd_barrier(const XcdBarrier& b) {
    asm volatile("s_waitcnt vmcnt(0)" ::: "memory");
    __syncthreads();
    if (threadIdx.x == 0) {
        unsigned* bar = b.bar;
        __builtin_amdgcn_s_waitcnt(0);
        unsigned nloc = b.st[0], nx = b.st[1];
        if (nloc == 0u) { xcd_barrier_complete(bar, b.x, nloc, nx); b.st[0] = nloc; b.st[1] = nx; }
        const unsigned old = xb_add(&bar[XB_XSUB(b.x)], 1u);
        const unsigned gen = old / nloc;
        if (old + 1u == (gen + 1u) * nloc) {
            __builtin_amdgcn_fence(__ATOMIC_RELEASE, "agent");
            asm volatile("s_waitcnt vmcnt(0)" ::: "memory");
            const unsigned og = xb_add(&bar[XB_TOP], 1u);
            const unsigned tg = og / nx;
            if (og + 1u == (tg + 1u) * nx) xb_add(&bar[XB_TOPGEN], 1u);
            else XB_SPIN(xb_ld(&bar[XB_TOPGEN]) == tg, bar);
            __builtin_amdgcn_fence(__ATOMIC_ACQUIRE, "agent");
            xb_add(&bar[XB_XGEN(b.x)], 1u);
            asm volatile("s_waitcnt vmcnt(0)" ::: "memory");
        } else {
            XB_SPIN(xb_ld(&bar[XB_XGEN(b.x)]) == gen, bar);
            __builtin_amdgcn_fence(__ATOMIC_ACQUIRE, "agent");
            asm volatile("s_waitcnt vmcnt(0)" ::: "memory");
        }
    }
    __syncthreads();
}

#define SEQ 8192
#define NTOK 16384
#define DM 1024
#define NLAYER 2
#define INCOLS 2716
#define ZLD 2720
#define Z_MQ 0
#define Z_MK 256
#define Z_NQ 768
#define Z_KC 1024
#define Z_VC 1088
#define Z_KS 1152
#define Z_KW 1280
#define Z_GATE 1408
#define Z_POOL 1424
#define Z_GQ 1680
#define Z_GK 1936
#define Z_GV 2192
#define Z_GA 2448
#define Z_GG 2464
#define NEXP 256
#define ALPHA 1.41421356237f
#define LN_EPS 1e-5f

#define WS_BAR   0ull
#define WS_QCTR  16384ull
#define WS_CNT   32768ull
#define CSTR     32
#define WS_ZERO_BYTES 163840ull
#define WS_ROPE  163840ull
#define WS_MOD   (WS_ROPE + 8192ull * 8 * 8)
#define WS_PBIAS 802816ull
#define WS_XA    (1ull << 20)
#define WS_XB    (WS_XA + 67108864ull)
#define WS_H     (WS_XB + 67108864ull)
#define WS_Z     (WS_H + 33554432ull)
#define WS_QROT  (WS_Z + 16384ull * ZLD * 2)
#define WS_VTM   (WS_QROT + 16384ull * 256 * 2)
#define WS_VTS   (WS_VTM + 2ull * 4 * 64 * 8192 * 2)
#define WS_VTW   (WS_VTS + 2ull * 64 * 8192 * 2)
#define WS_KMEAN (WS_VTW + 2ull * 64 * 8192 * 2)
#define WS_KC    (WS_KMEAN + 2ull * 4 * 32 * 64 * 4)
#define WS_VCT   (WS_KC + 2ull * 512 * 64 * 2)
#define WS_BCUM  (WS_VCT + 2ull * 512 * 64 * 2)
#define WS_U     (WS_BCUM + 16384ull * 256 * 4)
#define WS_AEND  (WS_U + 2ull * 4 * 128 * 4096 * 4)
#define WS_OCAT  (WS_AEND + 2ull * 4 * 128 * 64 * 4)
#define WS_R1    (WS_OCAT + 33554432ull)
#define WS_LOGIT (WS_R1 + 67108864ull)
#define WS_EW    (WS_LOGIT + 16384ull * 256 * 4)
#define WS_LIST  (WS_EW + 16384ull * 8 * 4)
#define WS_HID   (WS_LIST + 256ull * 16384 * 4)
#define WS_SLOT  (WS_HID + (131072ull + 16384) * 256 * 2)
#define WS_YSH   (WS_SLOT + 16384ull * 8 * 1024 * 2)
#define WS_CPART (WS_YSH + 33554432ull)
#define WS_WT    (WS_CPART + 8ull * 2 * 1024 * 128 * 4)
#define WT_IN    0ull
#define WT_OUT   (2816ull * 1024)
#define WT_R     (WT_OUT + 1024ull * 1024)
#define WT_SGU   (WT_R + 256ull * 1024)
#define WT_SD    (WT_SGU + 512ull * 1024)
#define WT_W1    (WT_SD + 1024ull * 256)
#define WT_LAYER (WT_W1 + 2ull * 128 * 2048)
#define WS_END   (WS_WT + 2ull * WT_LAYER * 2)

#define SMEM_BYTES 73728

#define rope  ((float2*)(ws + WS_ROPE))
#define modb  ((float*)(ws + WS_MOD))
#define xA    ((float*)(ws + WS_XA))
#define xB    ((float*)(ws + WS_XB))
#define hbuf  ((bf16_t*)(ws + WS_H))
#define zb    ((bf16_t*)(ws + WS_Z))
#define qrot  ((bf16_t*)(ws + WS_QROT))
#define vtm   ((bf16_t*)(ws + WS_VTM))
#define vts   ((bf16_t*)(ws + WS_VTS))
#define vtw   ((bf16_t*)(ws + WS_VTW))
#define kmean ((float*)(ws + WS_KMEAN))
#define kcb   ((bf16_t*)(ws + WS_KC))
#define vct   ((bf16_t*)(ws + WS_VCT))
#define bcum  ((float*)(ws + WS_BCUM))
#define Ub    ((float*)(ws + WS_U))
#define aend  ((float*)(ws + WS_AEND))
#define ocat  ((bf16_t*)(ws + WS_OCAT))
#define r1    ((float*)(ws + WS_R1))
#define hb8   ((unsigned char*)(ws + WS_XB + 33554432ull))
#define hscl8 ((unsigned char*)(ws + WS_XB + 33554432ull + 16777216ull))
#define r1h   ((bf16_t*)(ws + WS_R1))
#define xAh   ((bf16_t*)(ws + WS_XA))
#define xBh   ((bf16_t*)(ws + WS_XB))
#define logit ((float*)(ws + WS_LOGIT))
#define ewb   ((float*)(ws + WS_EW))
#define listb ((int*)(ws + WS_LIST))
#define hid   ((bf16_t*)(ws + WS_HID))
#define slot  ((bf16_t*)(ws + WS_SLOT))
#define slot8 ((unsigned char*)(ws + WS_SLOT))
#define sscl  ((unsigned char*)(ws + WS_SLOT + 134217728ull))
#define ysh   ((bf16_t*)(ws + WS_YSH))
#define cntb  ((unsigned*)(ws + WS_CNT))
#define cpart ((float*)(ws + WS_CPART))
#define pbias ((float*)(ws + WS_PBIAS))
#define WTL(L_) ((bf16_t*)(ws + WS_WT) + (size_t)(L_) * WT_LAYER)
#define QCTR(L_, i_) ((unsigned*)(ws + WS_QCTR + ((size_t)(L_) * 16 + (i_)) * 256))

struct Params {
    const float *x, *c, *w_ada, *b_ada, *w_in, *cmp_pe, *cmp_w1, *cmp_w2, *pool_w, *pool_scale, *gla_wa, *gla_ba, *gla_norm,
                *w_out, *ln_g, *ln_b, *w_router, *router_bias, *exp_gate, *exp_up, *exp_down, *sh_gate, *sh_up, *sh_down;
    float* out; unsigned char* ws;
};

__device__ __forceinline__ unsigned pack2(float lo, float hi) { f32x2_t v = {lo, hi}; bf16x2_t b = __builtin_convertvector(v, bf16x2_t); return *(unsigned*)&b; }
__device__ __forceinline__ float bflo(unsigned u) { return __uint_as_float(u << 16); }
__device__ __forceinline__ float bfhi(unsigned u) { return __uint_as_float(u & 0xffff0000u); }
__device__ __forceinline__ float bf2f(bf16_t h) { return __uint_as_float(((unsigned)h) << 16); }
__device__ __forceinline__ bf16_t f2bf(float f) { return (bf16_t)(pack2(f, 0.f) & 0xffffu); }
__device__ __forceinline__ int swz(int row, int chunk) { return row * 128 + (((chunk ^ ((row >> 2) ^ row)) & 7) << 4); }
__device__ __forceinline__ void glds16(const bf16_t* gp, unsigned char* lp) { __builtin_amdgcn_global_load_lds((const unsigned*)gp, (unsigned*)lp, 16, 0, 0); }
__device__ __forceinline__ float sigmoidf_(float x) { return __builtin_amdgcn_rcpf(1.f + __expf(-x)); }
__device__ __forceinline__ float siluf_(float x) { return x * __builtin_amdgcn_rcpf(1.f + __expf(-x)); }
#define NEG_INF (-__builtin_huge_valf())
__device__ __forceinline__ float xr_max(float v) {
    unsigned u = __float_as_uint(v); auto r = __builtin_amdgcn_permlane16_swap(u, u, false, false);
    v = __builtin_elementwise_maximum(__uint_as_float(r[0]), __uint_as_float(r[1]));
    u = __float_as_uint(v); auto r2 = __builtin_amdgcn_permlane32_swap(u, u, false, false);
    return __builtin_elementwise_maximum(__uint_as_float(r2[0]), __uint_as_float(r2[1]));
}
__device__ __forceinline__ float xr_sum(float v) {
    unsigned u = __float_as_uint(v); auto r = __builtin_amdgcn_permlane16_swap(u, u, false, false);
    v = __uint_as_float(r[0]) + __uint_as_float(r[1]);
    u = __float_as_uint(v); auto r2 = __builtin_amdgcn_permlane32_swap(u, u, false, false);
    return __uint_as_float(r2[0]) + __uint_as_float(r2[1]);
}
#define EXP2(x) __builtin_amdgcn_exp2f(x)
typedef unsigned long long u64_t;
template <int CTRL> __device__ __forceinline__ float dppf(float v) { return __uint_as_float(__builtin_amdgcn_update_dpp(0u, __float_as_uint(v), CTRL, 0xf, 0xf, true)); }
template <int CTRL> __device__ __forceinline__ u64_t dpp64(u64_t v) {
    const unsigned lo = __builtin_amdgcn_update_dpp(0u, (unsigned)v, CTRL, 0xf, 0xf, true), hi = __builtin_amdgcn_update_dpp(0u, (unsigned)(v >> 32), CTRL, 0xf, 0xf, true);
    return ((u64_t)hi << 32) | lo; }
__device__ __forceinline__ float wave_sum(float v) {
    v += dppf<0xB1>(v); v += dppf<0x4E>(v); v += dppf<0x141>(v); v += dppf<0x140>(v);
    return xr_sum(v);
}
__device__ __forceinline__ u64_t max64(u64_t a, u64_t b) { return a > b ? a : b; }
__device__ __forceinline__ u64_t wave_max64(u64_t v) {
    v = max64(v, dpp64<0xB1>(v)); v = max64(v, dpp64<0x4E>(v)); v = max64(v, dpp64<0x141>(v)); v = max64(v, dpp64<0x140>(v));
    { const unsigned lo = (unsigned)v, hi = (unsigned)(v >> 32); auto a = __builtin_amdgcn_permlane16_swap(lo, lo, false, false); auto b = __builtin_amdgcn_permlane16_swap(hi, hi, false, false);
      v = max64(((u64_t)b[0] << 32) | a[0], ((u64_t)b[1] << 32) | a[1]); }
    { const unsigned lo = (unsigned)v, hi = (unsigned)(v >> 32); auto a = __builtin_amdgcn_permlane32_swap(lo, lo, false, false); auto b = __builtin_amdgcn_permlane32_swap(hi, hi, false, false);
      v = max64(((u64_t)b[0] << 32) | a[0], ((u64_t)b[1] << 32) | a[1]); }
    return v;
}


template <int BM, int WM, class AOF, class BOF, class EPF>
__device__ __forceinline__ void gemm_dma(unsigned char* smem, const int t, int nkt, const bf16_t* abase, AOF arow, long akstride, const bf16_t* bbase, BOF brow, EPF epi) {
    constexpr int WN = 4 / WM, MI = BM / (16 * WM), NI = 128 / (16 * WN), AJ = BM / 32;
    const int lane = t & 63, wid = __builtin_amdgcn_readfirstlane(t >> 6), wr = wid / WN, wc = wid % WN, fr = lane & 15, g = lane >> 4;
    unsigned ao[AJ], bo[4];
#pragma unroll
    for (int j = 0; j < AJ; ++j) { const int row = 8 * (wid * AJ + j) + (lane >> 3); const int c = ((lane & 7) ^ ((row >> 2) ^ row)) & 7; ao[j] = arow(row) + (unsigned)(c * 8); }
#pragma unroll
    for (int j = 0; j < 4; ++j) { const int row = 8 * (wid * 4 + j) + (lane >> 3); const int c = ((lane & 7) ^ ((row >> 2) ^ row)) & 7; bo[j] = brow(row) + (unsigned)(c * 8); }
    f32x4 acc[MI][NI];
#pragma unroll
    for (int m = 0; m < MI; ++m)
#pragma unroll
        for (int n = 0; n < NI; ++n) acc[m][n] = (f32x4){0.f, 0.f, 0.f, 0.f};
    auto issue = [&](int kt) {
        unsigned char* sA = smem + (kt & 1) * 32768; unsigned char* sB = sA + 16384;
        const bf16_t* ab = abase + (long)kt * akstride; const bf16_t* bb = bbase + kt * 64;
#pragma unroll
        for (int j = 0; j < AJ; ++j) glds16(ab + ao[j], sA + (wid * AJ + j) * 1024);
#pragma unroll
        for (int j = 0; j < 4; ++j) glds16(bb + bo[j], sB + (wid * 4 + j) * 1024);
    };
    issue(0);
    for (int kt = 0; kt < nkt; ++kt) {
        asm volatile("s_waitcnt vmcnt(0)" ::: "memory");
        __syncthreads();
        if (kt + 1 < nkt) issue(kt + 1);
        const unsigned char* sA = smem + (kt & 1) * 32768; const unsigned char* sB = sA + 16384;
#pragma unroll
        for (int ks = 0; ks < 2; ++ks) {
            bf16x8 a[MI], b[NI];
#pragma unroll
            for (int m = 0; m < MI; ++m) a[m] = *(const bf16x8*)(sA + swz(wr * (BM / WM) + m * 16 + fr, ks * 4 + g));
#pragma unroll
            for (int n = 0; n < NI; ++n) b[n] = *(const bf16x8*)(sB + swz(wc * (128 / WN) + n * 16 + fr, ks * 4 + g));
#pragma unroll
            for (int m = 0; m < MI; ++m)
#pragma unroll
                for (int n = 0; n < NI; ++n) acc[m][n] = __builtin_amdgcn_mfma_f32_16x16x32_bf16(b[n], a[m], acc[m][n], 0, 0, 0);
        }
    }
    __syncthreads();
    epi(acc, wr, wc, fr, g);
}

template <int WM, class AOF, class EPF>
__device__ __forceinline__ void gemm_fb(unsigned char* smem, const int t, int NT, int nkt, const bf16_t* abase, AOF arow, const float* b0, const float* b1, long bstep, long ldb, EPF epi) {
    constexpr int WN = 4 / WM, MI = 128 / (16 * WM), NI = 128 / (16 * WN);
    const int lane = t & 63, wid = __builtin_amdgcn_readfirstlane(t >> 6), wr = wid / WN, wc = wid % WN, fr = lane & 15, g = lane >> 4;
    unsigned ao[4];
#pragma unroll
    for (int j = 0; j < 4; ++j) { const int row = 8 * (wid * 4 + j) + (lane >> 3); const int c = ((lane & 7) ^ ((row >> 2) ^ row)) & 7; ao[j] = arow(row) + (unsigned)(c * 8); }
    const int ng = (t & 7) + 8 * ((t >> 4) & 1), kg = ((t >> 3) & 1) + 2 * (t >> 5);
    const unsigned boff = (unsigned)(kg * 4) * (unsigned)ldb + (unsigned)(ng * 4);
    const int prow = ((((ng >> 3) & 1) * 2 + (ng & 1)) * 16) + 4 * ((ng >> 1) & 3);
    float4 bq[2][4];
    f32x4 acc[MI][NI];
#pragma unroll
    for (int m = 0; m < MI; ++m)
#pragma unroll
        for (int n = 0; n < NI; ++n) acc[m][n] = (f32x4){0.f, 0.f, 0.f, 0.f};
    const int nsteps = NT * nkt;
    auto issueA = [&](int s) {
        const int kt = s % nkt;
        unsigned char* sA = smem + (s & 1) * 16384;
        const bf16_t* ab = abase + kt * 64;
#pragma unroll
        for (int j = 0; j < 4; ++j) glds16(ab + ao[j], sA + (wid * 4 + j) * 1024);
    };
    auto loadB = [&](int s) {
        const int nt = s / nkt, kt = s % nkt;
        const float* p0 = b0 + (long)nt * bstep + (long)kt * 64 * ldb + boff; const float* p1 = b1 + (long)nt * bstep + (long)kt * 64 * ldb + boff;
#pragma unroll
        for (int i = 0; i < 4; ++i) { bq[0][i] = *(const float4*)(p0 + (long)i * ldb); bq[1][i] = *(const float4*)(p1 + (long)i * ldb); }
    };
    auto storeB = [&](int s) {
        unsigned char* sB = smem + 32768 + (s & 1) * 16384;
#pragma unroll
        for (int pp = 0; pp < 2; ++pp) {
            const float q0[4] = {bq[pp][0].x, bq[pp][0].y, bq[pp][0].z, bq[pp][0].w}, q1[4] = {bq[pp][1].x, bq[pp][1].y, bq[pp][1].z, bq[pp][1].w};
            const float q2[4] = {bq[pp][2].x, bq[pp][2].y, bq[pp][2].z, bq[pp][2].w}, q3[4] = {bq[pp][3].x, bq[pp][3].y, bq[pp][3].z, bq[pp][3].w};
#pragma unroll
            for (int i = 0; i < 4; ++i) { uint2 w; w.x = pack2(q0[i], q1[i]); w.y = pack2(q2[i], q3[i]);
                *(uint2*)(sB + swz(pp * 64 + prow + i, kg >> 1) + (kg & 1) * 8) = w; }
        }
    };
    issueA(0); loadB(0);
    asm volatile("s_waitcnt vmcnt(0)" ::: "memory");
    storeB(0);
    if (nsteps > 1) loadB(1);
    for (int s = 0; s < nsteps; ++s) {
        asm volatile("s_waitcnt vmcnt(0)" ::: "memory");
        __syncthreads();
        if (s + 1 < nsteps) { storeB(s + 1); issueA(s + 1); if (s + 2 < nsteps) loadB(s + 2); }
        const unsigned char* sA = smem + (s & 1) * 16384; const unsigned char* sB = smem + 32768 + (s & 1) * 16384;
#pragma unroll
        for (int ks = 0; ks < 2; ++ks) {
            bf16x8 a[MI], b[NI];
#pragma unroll
            for (int m = 0; m < MI; ++m) a[m] = *(const bf16x8*)(sA + swz(wr * (128 / WM) + m * 16 + fr, ks * 4 + g));
#pragma unroll
            for (int n = 0; n < NI; ++n) b[n] = *(const bf16x8*)(sB + swz(wc * (128 / WN) + n * 16 + fr, ks * 4 + g));
#pragma unroll
            for (int m = 0; m < MI; ++m)
#pragma unroll
                for (int n = 0; n < NI; ++n) acc[m][n] = __builtin_amdgcn_mfma_f32_16x16x32_bf16(b[n], a[m], acc[m][n], 0, 0, 0);
        }
        if ((s + 1) % nkt == 0) {
            epi(acc, s / nkt, wr, wc, fr, g);
#pragma unroll
            for (int m = 0; m < MI; ++m)
#pragma unroll
                for (int n = 0; n < NI; ++n) acc[m][n] = (f32x4){0.f, 0.f, 0.f, 0.f};
        }
    }
    __syncthreads();
}

template <class AOF, class EPF>
__device__ __forceinline__ void gemm_fbr(unsigned char* smem, const int t, int NT, const bf16_t* abase, AOF arow, const float* b0, const float* b1, long bstep, long ldb, EPF epi) {
    const int lane = t & 63, wid = __builtin_amdgcn_readfirstlane(t >> 6), fr = lane & 15, g = lane >> 4;
    bf16x8 afr[2][8];
#pragma unroll
    for (int m = 0; m < 2; ++m) { const bf16_t* ap = abase + arow(wid * 32 + m * 16 + fr) + g * 8;
#pragma unroll
        for (int ks = 0; ks < 8; ++ks) afr[m][ks] = *(const bf16x8*)(ap + ks * 32); }
    const int ng = (t & 7) + 8 * ((t >> 4) & 1), kg = ((t >> 3) & 1) + 2 * (t >> 5);
    const unsigned boff = (unsigned)(kg * 4) * (unsigned)ldb + (unsigned)(ng * 4);
    const int prow = ((((ng >> 3) & 1) * 2 + (ng & 1)) * 16) + 4 * ((ng >> 1) & 3);
    float4 bq[2][4];
    f32x4 acc[2][8];
#pragma unroll
    for (int m = 0; m < 2; ++m)
#pragma unroll
        for (int n = 0; n < 8; ++n) acc[m][n] = (f32x4){0.f, 0.f, 0.f, 0.f};
    const int nsteps = NT * 4;
    auto loadB = [&](int s) {
        const int nt = s >> 2, kt = s & 3;
        const float* p0 = b0 + (long)nt * bstep + (long)kt * 64 * ldb + boff; const float* p1 = b1 + (long)nt * bstep + (long)kt * 64 * ldb + boff;
#pragma unroll
        for (int i = 0; i < 4; ++i) { bq[0][i] = *(const float4*)(p0 + (long)i * ldb); bq[1][i] = *(const float4*)(p1 + (long)i * ldb); }
    };
    auto storeB = [&](int s) {
        unsigned char* sB = smem + (s & 1) * 16384;
#pragma unroll
        for (int pp = 0; pp < 2; ++pp) {
            const float q0[4] = {bq[pp][0].x, bq[pp][0].y, bq[pp][0].z, bq[pp][0].w}, q1[4] = {bq[pp][1].x, bq[pp][1].y, bq[pp][1].z, bq[pp][1].w};
            const float q2[4] = {bq[pp][2].x, bq[pp][2].y, bq[pp][2].z, bq[pp][2].w}, q3[4] = {bq[pp][3].x, bq[pp][3].y, bq[pp][3].z, bq[pp][3].w};
#pragma unroll
            for (int i = 0; i < 4; ++i) { uint2 w; w.x = pack2(q0[i], q1[i]); w.y = pack2(q2[i], q3[i]);
                *(uint2*)(sB + swz(pp * 64 + prow + i, kg >> 1) + (kg & 1) * 8) = w; }
        }
    };
    loadB(0);
    storeB(0);
    loadB(1);
    for (int nt = 0; nt < NT; ++nt) {
#pragma unroll
        for (int kt = 0; kt < 4; ++kt) {
            const int s = nt * 4 + kt;
            __syncthreads();
            if (s + 1 < nsteps) { storeB(s + 1); if (s + 2 < nsteps) loadB(s + 2); }
            const unsigned char* sB = smem + (kt & 1) * 16384;
#pragma unroll
            for (int ks = 0; ks < 2; ++ks) {
#pragma unroll
                for (int nh2 = 0; nh2 < 2; ++nh2) {
                    bf16x8 b[4];
#pragma unroll
                    for (int n = 0; n < 4; ++n) b[n] = *(const bf16x8*)(sB + swz((nh2 * 4 + n) * 16 + fr, ks * 4 + g));
#pragma unroll
                    for (int m = 0; m < 2; ++m)
#pragma unroll
                        for (int n = 0; n < 4; ++n) acc[m][nh2 * 4 + n] = __builtin_amdgcn_mfma_f32_16x16x32_bf16(b[n], afr[m][2 * kt + ks], acc[m][nh2 * 4 + n], 0, 0, 0);
                    __builtin_amdgcn_sched_barrier(0);
                }
            }
        }
        epi(acc, nt, wid, fr, g);
#pragma unroll
        for (int m = 0; m < 2; ++m)
#pragma unroll
            for (int n = 0; n < 8; ++n) acc[m][n] = (f32x4){0.f, 0.f, 0.f, 0.f};
    }
    __syncthreads();
}

__device__ __forceinline__ int swz32(int row, int chunk) { return row * 64 + (((chunk ^ (0 - (row >> 2))) & 3) << 4); }
__device__ __forceinline__ void glds16_asm(const void* g, unsigned lds_base) {
    unsigned sv; asm volatile("s_mov_b32 %0, m0\n\ts_mov_b32 m0, %2\n\ts_nop 0\n\tglobal_load_lds_dwordx4 %1, off\n\ts_mov_b32 m0, %0" : "=&s"(sv) : "v"(g), "s"(lds_base) : "memory"); }
template <class AOF, class EPF>
__device__ __forceinline__ void gemm_fb256(unsigned char* smem, const int t, int nk, const bf16_t* abase, AOF arow, const float* b0, const float* b1, long ldb, EPF epi) {
    const int lane = t & 63, wid = __builtin_amdgcn_readfirstlane(t >> 6), fr = lane & 15, g = lane >> 4;
    const unsigned lds0 = (unsigned)(uintptr_t)smem;
    unsigned ao[4];
#pragma unroll
    for (int j = 0; j < 4; ++j) { const int row = 16 * (wid * 4 + j) + (lane >> 2); const int c = ((lane & 3) ^ (0 - (row >> 2))) & 3; ao[j] = arow(row) + (unsigned)(c * 8); }
    const int ng = t & 15, kg = (t >> 4) & 7, pp = t >> 7;
    const float* bsrc = (pp ? b1 : b0) + (long)(kg * 4) * ldb + ng * 4;
    const int prow = pp * 64 + ((((ng >> 3) & 1) * 2 + (ng & 1)) * 16) + 4 * ((ng >> 1) & 3);
    f32x4 bqa[4], bqb[4];
    f32x4 acc[4][8];
#pragma unroll
    for (int m = 0; m < 4; ++m)
#pragma unroll
        for (int n = 0; n < 8; ++n) acc[m][n] = (f32x4){0.f, 0.f, 0.f, 0.f};
    auto issueA = [&](int s, int sbuf) {
        const unsigned sA = lds0 + (sbuf & 1) * 16384 + wid * 4096;
        const bf16_t* ab = abase + s * 32;
#pragma unroll
        for (int j = 0; j < 4; ++j) glds16_asm(ab + ao[j], sA + j * 1024);
    };
#define FB_LOADB(S_, BQ_) { const float* p0_ = bsrc + (long)(S_) * 32 * 256; \
        asm volatile("global_load_dwordx4 %0, %4, off\n\tglobal_load_dwordx4 %1, %4, off offset:1024\n\tglobal_load_dwordx4 %2, %4, off offset:2048\n\tglobal_load_dwordx4 %3, %4, off offset:3072" \
                     : "=&v"(BQ_[0]), "=&v"(BQ_[1]), "=&v"(BQ_[2]), "=&v"(BQ_[3]) : "v"(p0_) : "memory"); }
#define FB_WAIT(N_, BQ_) asm volatile("s_waitcnt vmcnt(" #N_ ")" : "+v"(BQ_[0]), "+v"(BQ_[1]), "+v"(BQ_[2]), "+v"(BQ_[3]) :: "memory")
#define FB_STOREB(S_, BQ_) { unsigned char* sB_ = smem + 32768 + ((S_) & 1) * 8192; \
        { uint2 w_; w_.x = pack2(BQ_[0][0], BQ_[1][0]); w_.y = pack2(BQ_[2][0], BQ_[3][0]); *(uint2*)(sB_ + swz32(prow + 0, kg >> 1) + (kg & 1) * 8) = w_; } \
        { uint2 w_; w_.x = pack2(BQ_[0][1], BQ_[1][1]); w_.y = pack2(BQ_[2][1], BQ_[3][1]); *(uint2*)(sB_ + swz32(prow + 1, kg >> 1) + (kg & 1) * 8) = w_; } \
        { uint2 w_; w_.x = pack2(BQ_[0][2], BQ_[1][2]); w_.y = pack2(BQ_[2][2], BQ_[3][2]); *(uint2*)(sB_ + swz32(prow + 2, kg >> 1) + (kg & 1) * 8) = w_; } \
        { uint2 w_; w_.x = pack2(BQ_[0][3], BQ_[1][3]); w_.y = pack2(BQ_[2][3], BQ_[3][3]); *(uint2*)(sB_ + swz32(prow + 3, kg >> 1) + (kg & 1) * 8) = w_; } }
    auto compute = [&](int s) {
        const unsigned char* sA = smem + (s & 1) * 16384; const unsigned char* sB = smem + 32768 + (s & 1) * 8192;
        bf16x8 a[4], b[8];
#pragma unroll
        for (int m = 0; m < 4; ++m) a[m] = *(const bf16x8*)(sA + swz32(wid * 64 + m * 16 + fr, g));
#pragma unroll
        for (int n = 0; n < 8; ++n) b[n] = *(const bf16x8*)(sB + swz32(n * 16 + fr, g));
#pragma unroll
        for (int m = 0; m < 4; ++m)
#pragma unroll
            for (int n = 0; n < 8; ++n) acc[m][n] = __builtin_amdgcn_mfma_f32_16x16x32_bf16(b[n], a[m], acc[m][n], 0, 0, 0);
    };
#define FB_STEP(S_, BQ_) { const int s_ = (S_); \
        FB_WAIT(4, BQ_); \
        __syncthreads(); \
        FB_STOREB(s_ + 1, BQ_) issueA(s_ + 1 < nk ? s_ + 1 : nk - 1, s_ + 1); \
        FB_LOADB((s_ + 3 < nk ? s_ + 3 : nk - 1), BQ_) \
        compute(s_); }
    issueA(0, 0); FB_LOADB(0, bqa) FB_LOADB(1, bqb)
    FB_WAIT(4, bqa);
    FB_STOREB(0, bqa)
    FB_LOADB(2, bqa)
    for (int s = 0; s < nk; s += 2) { FB_STEP(s, bqb) FB_STEP(s + 1, bqa) }
    FB_WAIT(0, bqa); FB_WAIT(0, bqb);
    __syncthreads();
    epi(acc, wid, fr, g);
}
#undef FB_LOADB
#undef FB_WAIT
#undef FB_STOREB
#undef FB_STEP

template <class AOF, class EPF>
__device__ __forceinline__ void gemm_f8_256(unsigned char* smem, const int t, int nk, const unsigned char* abase8, AOF arow, const float* b0, const float* b1, long ldb, EPF epi) {
    const int lane = t & 63, wid = __builtin_amdgcn_readfirstlane(t >> 6), fr = lane & 15, g = lane >> 4;
    unsigned ao[4];
#pragma unroll
    for (int j = 0; j < 4; ++j) { const int row = 16 * (wid * 4 + j) + (lane >> 2); const int c = ((lane & 3) ^ (0 - (row >> 2))) & 3; ao[j] = arow(row) + (unsigned)(c * 16); }
    const int ng = t & 15, kg = (t >> 4) & 7, pp = t >> 7;
    const float* bsrc = (pp ? b1 : b0) + (long)(kg * 8) * ldb + ng * 4;
    const int prow = pp * 64 + ((((ng >> 3) & 1) * 2 + (ng & 1)) * 16) + 4 * ((ng >> 1) & 3);
    const unsigned fo0 = (unsigned)(fr * 64 + ((((g >> 1) ^ (0 - (fr >> 2))) & 3) << 4) + (g & 1) * 8), fo1 = fo0 ^ 32u;
    float4 bq[8];
    f32x4 acc[4][8];
#pragma unroll
    for (int m = 0; m < 4; ++m)
#pragma unroll
        for (int n = 0; n < 8; ++n) acc[m][n] = (f32x4){0.f, 0.f, 0.f, 0.f};
    auto issueA = [&](int s) {
        unsigned char* sA = smem + (s & 1) * 16384;
        const unsigned char* ab = abase8 + s * 64;
#pragma unroll
        for (int j = 0; j < 4; ++j) glds16((const bf16_t*)(ab + ao[j]), sA + (wid * 4 + j) * 1024);
    };
    auto loadB = [&](int s) {
        const float* p0 = bsrc + (long)s * 64 * ldb;
#pragma unroll
        for (int i = 0; i < 8; ++i) bq[i] = *(const float4*)(p0 + (long)i * ldb);
    };
    auto storeB = [&](int s) {
        unsigned char* sB = smem + 32768 + (s & 1) * 8192;
        const float q0[4] = {bq[0].x, bq[0].y, bq[0].z, bq[0].w}, q1[4] = {bq[1].x, bq[1].y, bq[1].z, bq[1].w}, q2[4] = {bq[2].x, bq[2].y, bq[2].z, bq[2].w}, q3[4] = {bq[3].x, bq[3].y, bq[3].z, bq[3].w};
        const float q4[4] = {bq[4].x, bq[4].y, bq[4].z, bq[4].w}, q5[4] = {bq[5].x, bq[5].y, bq[5].z, bq[5].w}, q6[4] = {bq[6].x, bq[6].y, bq[6].z, bq[6].w}, q7[4] = {bq[7].x, bq[7].y, bq[7].z, bq[7].w};
#pragma unroll
        for (int i = 0; i < 4; ++i) {
            int w0 = __builtin_amdgcn_cvt_pk_bf8_f32(q0[i], q1[i], 0, false); w0 = __builtin_amdgcn_cvt_pk_bf8_f32(q2[i], q3[i], w0, true);
            int w1 = __builtin_amdgcn_cvt_pk_bf8_f32(q4[i], q5[i], 0, false); w1 = __builtin_amdgcn_cvt_pk_bf8_f32(q6[i], q7[i], w1, true);
            uint2 w; w.x = (unsigned)w0; w.y = (unsigned)w1;
            *(uint2*)(sB + swz32(prow + i, kg >> 1) + (kg & 1) * 8) = w; }
    };
    issueA(0); loadB(0);
    asm volatile("s_waitcnt vmcnt(0)" ::: "memory");
    storeB(0);
    if (nk > 1) loadB(1);
    for (int s = 0; s < nk; ++s) {
        asm volatile("s_waitcnt vmcnt(0)" ::: "memory");
        __syncthreads();
        if (s + 1 < nk) { storeB(s + 1); issueA(s + 1); if (s + 2 < nk) loadB(s + 2); }
        __builtin_amdgcn_sched_barrier(0);
        const unsigned char* sA = smem + (s & 1) * 16384; const unsigned char* sB = smem + 32768 + (s & 1) * 8192;
        {
            const unsigned char* pa = sA + wid * 4096;
            long a0[4], a1[4], bA[4], bB[4];
#define G8_RA(A_, FO_) _Pragma("unroll") for (int m = 0; m < 4; ++m) A_[m] = *(const long*)(pa + FO_ + m * 1024);
#define G8_RB(B_, FO_, NH_) _Pragma("unroll") for (int n = 0; n < 4; ++n) B_[n] = *(const long*)(sB + FO_ + ((NH_) * 4 + n) * 1024);
#define G8_MM(A_, B_, NH_) _Pragma("unroll") for (int m = 0; m < 4; ++m) _Pragma("unroll") for (int n = 0; n < 4; ++n) \
                acc[m][(NH_) * 4 + n] = __builtin_amdgcn_mfma_f32_16x16x32_bf8_fp8(B_[n], A_[m], acc[m][(NH_) * 4 + n], 0, 0, 0);
            G8_RA(a0, fo0) G8_RB(bA, fo0, 0)
            __builtin_amdgcn_sched_barrier(0);
            G8_RB(bB, fo0, 1) G8_MM(a0, bA, 0)
            __builtin_amdgcn_sched_barrier(0);
            G8_RA(a1, fo1) G8_RB(bA, fo1, 0) G8_MM(a0, bB, 1)
            __builtin_amdgcn_sched_barrier(0);
            G8_RB(bB, fo1, 1) G8_MM(a1, bA, 0)
            __builtin_amdgcn_sched_barrier(0);
            G8_MM(a1, bB, 1)
#undef G8_RA
#undef G8_RB
#undef G8_MM
        }
    }
    __syncthreads();
    epi(acc, wid, fr, g);
}

template <class AOF, class BOF, class EPF>
__device__ __forceinline__ void gemm_dma256(unsigned char* smem, const int t, int nk, const bf16_t* abase, AOF arow, const bf16_t* bbase, BOF brow, EPF epi) {
    const int lane = t & 63, wid = __builtin_amdgcn_readfirstlane(t >> 6), fr = lane & 15, g = lane >> 4;
    unsigned ao[4], bo[2];
#pragma unroll
    for (int j = 0; j < 4; ++j) { const int row = 16 * (wid * 4 + j) + (lane >> 2); const int c = ((lane & 3) ^ (0 - (row >> 2))) & 3; ao[j] = arow(row) + (unsigned)(c * 8); }
#pragma unroll
    for (int j = 0; j < 2; ++j) { const int row = 16 * (wid * 2 + j) + (lane >> 2); const int c = ((lane & 3) ^ (0 - (row >> 2))) & 3; bo[j] = brow(row) + (unsigned)(c * 8); }
    f32x4 acc[4][8];
#pragma unroll
    for (int m = 0; m < 4; ++m)
#pragma unroll
        for (int n = 0; n < 8; ++n) acc[m][n] = (f32x4){0.f, 0.f, 0.f, 0.f};
    auto issue = [&](int s) {
        unsigned char* sA = smem + (s & 1) * 24576; unsigned char* sB = sA + 16384;
        const bf16_t* ab = abase + s * 32; const bf16_t* bb = bbase + s * 32;
#pragma unroll
        for (int j = 0; j < 4; ++j) glds16(ab + ao[j], sA + (wid * 4 + j) * 1024);
#pragma unroll
        for (int j = 0; j < 2; ++j) glds16(bb + bo[j], sB + (wid * 2 + j) * 1024);
    };
    issue(0);
    for (int s = 0; s < nk; ++s) {
        asm volatile("s_waitcnt vmcnt(0)" ::: "memory");
        __syncthreads();
        if (s + 1 < nk) issue(s + 1);
        const unsigned char* sA = smem + (s & 1) * 24576; const unsigned char* sB = sA + 16384;
        bf16x8 a[4], b[8];
#pragma unroll
        for (int m = 0; m < 4; ++m) a[m] = *(const bf16x8*)(sA + swz32(wid * 64 + m * 16 + fr, g));
#pragma unroll
        for (int n = 0; n < 8; ++n) b[n] = *(const bf16x8*)(sB + swz32(n * 16 + fr, g));
#pragma unroll
        for (int m = 0; m < 4; ++m)
#pragma unroll
            for (int n = 0; n < 8; ++n) acc[m][n] = __builtin_amdgcn_mfma_f32_16x16x32_bf16(b[n], a[m], acc[m][n], 0, 0, 0);
    }
    __syncthreads();
    epi(acc, wid, fr, g);
}

__device__ __forceinline__ void conv_block(const float* src, long ldn, int nvalid, bf16_t* dst, long dK, unsigned char* buf, const int t) {
    const int ng = t & 15, kg = t >> 4;
    float q[4][4];
#pragma unroll
    for (int i = 0; i < 4; ++i) {
        float4 v = make_float4(0.f, 0.f, 0.f, 0.f);
        if (ng * 4 < nvalid) v = *(const float4*)(src + (long)(kg * 4 + i) * ldn + ng * 4);
        q[i][0] = v.x; q[i][1] = v.y; q[i][2] = v.z; q[i][3] = v.w;
    }
#pragma unroll
    for (int i = 0; i < 4; ++i) {
        uint2 w; w.x = pack2(q[0][i], q[1][i]); w.y = pack2(q[2][i], q[3][i]);
        *(uint2*)(buf + (ng * 4 + i) * 128 + ((kg ^ ((ng & 7) << 1)) << 3)) = w;
    }
    __syncthreads();
#pragma unroll
    for (int ps = 0; ps < 2; ++ps) {
        const int row = (t >> 3) + 32 * ps, c16 = t & 7;
        const uint4 v = *(const uint4*)(buf + row * 128 + (((2 * c16) ^ (((row >> 2) & 7) << 1)) << 3));
        *(uint4*)(dst + (long)row * dK + c16 * 8) = v;
    }
    __syncthreads();
}

struct AttnState { float m, l; f32x4 o[4]; };
__device__ __forceinline__ void attn_init(AttnState& s) { s.m = NEG_INF; s.l = 0.f;
#pragma unroll
    for (int i = 0; i < 4; ++i) s.o[i] = (f32x4){0.f, 0.f, 0.f, 0.f}; }

#define KEY_OF(ni, g, r) (32 * ((ni) >> 1) + 8 * (g) + 4 * ((ni) & 1) + (r))
struct FragBase { int kb, vb; };
__device__ __forceinline__ FragBase frag_base(int fr, int g) {
    const int rf = 8 * (fr >> 2) + (fr & 3), ke = ((2 * (fr >> 2)) ^ (fr & 3)) & 7, kfr = ((fr >> 2) ^ fr) & 7;
    FragBase f; f.kb = rf * 128 + ((g ^ ke) << 4); f.vb = fr * 128 + ((g ^ kfr) << 4);
    return f;
}
__device__ __forceinline__ void qk_tile(f32x4 (&s)[4], const unsigned char* sK, const bf16x8 (&q)[2], const FragBase& fb) {
#pragma unroll
    for (int ni = 0; ni < 4; ++ni) {
        s[ni] = (f32x4){0.f, 0.f, 0.f, 0.f};
#pragma unroll
        for (int ks = 0; ks < 2; ++ks) {
            const bf16x8 kf = *(const bf16x8*)(sK + (ni >> 1) * 4096 + (ni & 1) * 512 + (fb.kb ^ ((ni & 1) * 80) ^ (ks * 64)));
            s[ni] = __builtin_amdgcn_mfma_f32_16x16x32_bf16(kf, q[ks], s[ni], 0, 0, 0);
        }
    }
}
__device__ __forceinline__ void p_pack(bf16x8 (&pf)[2], const f32x4 (&s)[4]) {
#pragma unroll
    for (int kk = 0; kk < 2; ++kk) {
        union { bf16x8 v; unsigned u[4]; } pu;
        pu.u[0] = pack2(s[2 * kk][0], s[2 * kk][1]); pu.u[1] = pack2(s[2 * kk][2], s[2 * kk][3]);
        pu.u[2] = pack2(s[2 * kk + 1][0], s[2 * kk + 1][1]); pu.u[3] = pack2(s[2 * kk + 1][2], s[2 * kk + 1][3]);
        pf[kk] = pu.v;
    }
}
__device__ __forceinline__ void pv_tile(f32x4 (&o)[4], const unsigned char* sV, const bf16x8 (&pf)[2], const FragBase& fb) {
    bf16x8 vf[2][4];
#pragma unroll
    for (int kk = 0; kk < 2; ++kk)
#pragma unroll
        for (int mi = 0; mi < 4; ++mi) vf[kk][mi] = *(const bf16x8*)(sV + mi * 2048 + (fb.vb ^ (((kk ^ mi) & 1) << 6)));
#pragma unroll
    for (int kk = 0; kk < 2; ++kk)
#pragma unroll
        for (int mi = 0; mi < 4; ++mi) o[mi] = __builtin_amdgcn_mfma_f32_16x16x32_bf16(vf[kk][mi], pf[kk], o[mi], 0, 0, 0);
}
#define MAXM(a_, b_) __builtin_elementwise_maximum((a_), (b_))
__device__ __forceinline__ float max16m(const f32x4 (&s)[4]) {
    float a = MAXM(MAXM(s[0][0], s[0][1]), s[0][2]), b = MAXM(MAXM(s[2][0], s[2][1]), s[2][2]);
    a = MAXM(MAXM(a, s[0][3]), s[1][0]); b = MAXM(MAXM(b, s[2][3]), s[3][0]);
    a = MAXM(MAXM(a, s[1][1]), s[1][2]); b = MAXM(MAXM(b, s[3][1]), s[3][2]);
    return MAXM(MAXM(a, b), MAXM(s[1][3], s[3][3]));
}
#define RESCALE_THR 8.f
__device__ __forceinline__ void qk_tile_c(f32x4 (&s)[4], const unsigned char* sK, const bf16x8 (&q)[2], const FragBase& fb, const f32x4 cinit) {
#pragma unroll
    for (int ni = 0; ni < 4; ++ni) {
        s[ni] = cinit;
#pragma unroll
        for (int ks = 0; ks < 2; ++ks) {
            const bf16x8 kf = *(const bf16x8*)(sK + (ni >> 1) * 4096 + (ni & 1) * 512 + (fb.kb ^ ((ni & 1) * 80) ^ (ks * 64)));
            s[ni] = __builtin_amdgcn_mfma_f32_16x16x32_bf16(kf, q[ks], s[ni], 0, 0, 0);
        }
    }
}
__device__ __forceinline__ float max16v(const f32x4 (&s)[4]) {
    float a = fmaxf(fmaxf(s[0][0], s[0][1]), s[0][2]), b = fmaxf(fmaxf(s[2][0], s[2][1]), s[2][2]);
    a = fmaxf(fmaxf(a, s[0][3]), s[1][0]); b = fmaxf(fmaxf(b, s[2][3]), s[3][0]);
    a = fmaxf(fmaxf(a, s[1][1]), s[1][2]); b = fmaxf(fmaxf(b, s[3][1]), s[3][2]);
    return fmaxf(fmaxf(a, b), fmaxf(s[1][3], s[3][3]));
}
template <class MF>
__device__ __forceinline__ void attn_tile(AttnState& st, const unsigned char* sK, const unsigned char* sV, const bf16x8 (&q)[2], const FragBase& fb, int g, bool lane_ok, bool check, MF valid) {
    const bool first = (st.m == NEG_INF);
    const float cm = lane_ok ? (first ? 0.f : -st.m) : NEG_INF;
    f32x4 s[4];
    qk_tile_c(s, sK, q, fb, (f32x4){cm, cm, cm, cm});
    if (check) {
#pragma unroll
        for (int ni = 0; ni < 4; ++ni)
#pragma unroll
            for (int r = 0; r < 4; ++r) { if (!valid(KEY_OF(ni, g, r))) s[ni][r] = NEG_INF; }
    }
    const float gr = xr_max(max16m(s));
    if (__any(first ? (gr > NEG_INF) : (gr > RESCALE_THR))) {
        const float sh = (gr == NEG_INF) ? 0.f : (first ? gr : fmaxf(gr, 0.f));
        const float alpha = first ? 1.f : EXP2(-sh);
        st.m = (gr == NEG_INF) ? st.m : (first ? 0.f : st.m) + sh;
        const f32x4 nsh = (f32x4){-sh, -sh, -sh, -sh};
#pragma unroll
        for (int ni = 0; ni < 4; ++ni) s[ni] = s[ni] + nsh;
        st.l *= alpha;
#pragma unroll
        for (int mi = 0; mi < 4; ++mi) st.o[mi] *= alpha;
    }
    f32x4 av = (f32x4){0.f, 0.f, 0.f, 0.f};
#pragma unroll
    for (int ni = 0; ni < 4; ++ni) {
#pragma unroll
        for (int r = 0; r < 4; ++r) s[ni][r] = EXP2(s[ni][r]);
        av += s[ni];
    }
    st.l += xr_sum((av[0] + av[1]) + (av[2] + av[3]));
    bf16x8 pf[2];
    p_pack(pf, s);
    pv_tile(st.o, sV, pf, fb);
}

template <class MFA, class MFB>
__device__ __forceinline__ void attn_tile2(AttnState& st, const unsigned char* sKa, const unsigned char* sKb, const bf16x8 (&q)[2], const FragBase& fb, int g,
                                           bool okA, bool chkA, MFA validA, bool okB, bool chkB, MFB validB) {
    const bool first = (st.m == NEG_INF);
    const float cbase = first ? 0.f : -st.m, cmA = okA ? cbase : NEG_INF, cmB = okB ? cbase : NEG_INF;
    f32x4 sa[4], sb[4];
    qk_tile_c(sa, sKa, q, fb, (f32x4){cmA, cmA, cmA, cmA});
    qk_tile_c(sb, sKb, q, fb, (f32x4){cmB, cmB, cmB, cmB});
    if (chkA) {
#pragma unroll
        for (int ni = 0; ni < 4; ++ni)
#pragma unroll
            for (int r = 0; r < 4; ++r) { if (!validA(KEY_OF(ni, g, r))) sa[ni][r] = NEG_INF; }
    }
    if (chkB) {
#pragma unroll
        for (int ni = 0; ni < 4; ++ni)
#pragma unroll
            for (int r = 0; r < 4; ++r) { if (!validB(KEY_OF(ni, g, r))) sb[ni][r] = NEG_INF; }
    }
    const float gr = xr_max(MAXM(max16m(sa), max16m(sb)));
    if (__any(first ? (gr > NEG_INF) : (gr > RESCALE_THR))) {
        const float sh = (gr == NEG_INF) ? 0.f : (first ? gr : fmaxf(gr, 0.f));
        const float alpha = first ? 1.f : EXP2(-sh);
        st.m = (gr == NEG_INF) ? st.m : (first ? 0.f : st.m) + sh;
        const f32x4 nsh = (f32x4){-sh, -sh, -sh, -sh};
#pragma unroll
        for (int ni = 0; ni < 4; ++ni) { sa[ni] = sa[ni] + nsh; sb[ni] = sb[ni] + nsh; }
        st.l *= alpha;
#pragma unroll
        for (int mi = 0; mi < 4; ++mi) st.o[mi] *= alpha;
    }
    f32x4 av = (f32x4){0.f, 0.f, 0.f, 0.f};
#pragma unroll
    for (int ni = 0; ni < 4; ++ni) {
#pragma unroll
        for (int r = 0; r < 4; ++r) { sa[ni][r] = EXP2(sa[ni][r]); sb[ni][r] = EXP2(sb[ni][r]); }
        av += sa[ni]; av += sb[ni];
    }
    st.l += xr_sum((av[0] + av[1]) + (av[2] + av[3]));
    bf16x8 pfa[2], pfb[2];
    p_pack(pfa, sa); p_pack(pfb, sb);
    pv_tile(st.o, sKa + 8192, pfa, fb);
    pv_tile(st.o, sKb + 8192, pfb, fb);
}

__device__ __forceinline__ void tile_ld(const int t, const bf16_t* base, long ld, uint4& r0, uint4& r1v) {
    const int c = t & 7, row = t >> 3;
    r0 = *(const uint4*)(base + (long)row * ld + c * 8); r1v = *(const uint4*)(base + (long)(row + 32) * ld + c * 8);
}
__device__ __forceinline__ void tile_st(const int t, unsigned char* sX, const uint4& r0, const uint4& r1v) {
    const int c = t & 7, row = t >> 3;
    *(uint4*)(sX + swz(row, c)) = r0; *(uint4*)(sX + swz(row + 32, c)) = r1v;
}
template <class NF, class TF, class MF>
__device__ __forceinline__ void attn_run(const int t, AttnState& st, unsigned char* ring, const bf16_t* kbase, long kld, const bf16_t* vtbase, long vld,
                                         const bf16x8 (&q)[2], int fr, int g, NF next, TF tinfo, MF mask) {
    const int lane = t & 63, wid = __builtin_amdgcn_readfirstlane(t >> 6);
    unsigned ko[2], vo[2];
#pragma unroll
    for (int j = 0; j < 2; ++j) { const int row = 8 * (wid * 2 + j) + (lane >> 3); const int c = ((lane & 7) ^ ((row >> 2) ^ row)) & 7;
        ko[j] = (unsigned)(row * kld + c * 8); vo[j] = (unsigned)(row * vld + c * 8); }
    auto issue = [&](int kt, int stage) {
        unsigned char* sK = ring + stage * 16384 + wid * 2048; unsigned char* sV = sK + 8192;
        const bf16_t* kb = kbase + (long)kt * 64 * kld; const bf16_t* vb = vtbase + (long)kt * 64;
#pragma unroll
        for (int j = 0; j < 2; ++j) { glds16(kb + ko[j], sK + j * 1024); glds16(vb + vo[j], sV + j * 1024); }
    };
    const FragBase fb = frag_base(fr, g);
    int kA = __builtin_amdgcn_readfirstlane(next(-1)), kB = (kA >= 0) ? __builtin_amdgcn_readfirstlane(next(kA)) : -1;
    if (kA >= 0) issue(kA, 0);
    if (kB >= 0) issue(kB, 1);
    int i = 0;
    while (kA >= 0) {
        const int kC = (kB >= 0) ? __builtin_amdgcn_readfirstlane(next(kB)) : -1, kD = (kC >= 0) ? __builtin_amdgcn_readfirstlane(next(kC)) : -1;
        asm volatile("s_waitcnt vmcnt(0)" ::: "memory");
        asm volatile("s_waitcnt lgkmcnt(0)" ::: "memory"); __builtin_amdgcn_s_barrier(); asm volatile("" ::: "memory");
        const int sb = (i & 1) * 2;
        if (kC >= 0) issue(kC, sb ^ 2);
        if (kD >= 0) issue(kD, (sb ^ 2) + 1);
        const unsigned char* sKa = ring + sb * 16384; const unsigned char* sKb = sKa + 16384;
        bool okA, chkA; tinfo(kA, okA, chkA);
        if (kB >= 0) {
            bool okB, chkB; tinfo(kB, okB, chkB);
            attn_tile2(st, sKa, sKb, q, fb, g, okA, chkA, [&](int kl) { return mask(kA, kl); }, okB, chkB, [&](int kl) { return mask(kB, kl); });
        } else {
            attn_tile(st, sKa, sKa + 8192, q, fb, g, okA, chkA, [&](int kl) { return mask(kA, kl); });
        }
        kA = kC; kB = kD; ++i;
    }
    asm volatile("s_waitcnt lgkmcnt(0)" ::: "memory"); __builtin_amdgcn_s_barrier(); asm volatile("" ::: "memory");
}


template <class MF0, class MF1>
__device__ __forceinline__ void attn_tile_g2(AttnState& st0, AttnState& st1, const unsigned char* sK, const unsigned char* sV, const bf16x8 (&q0)[2], const bf16x8 (&q1)[2],
                                             const FragBase& fb, int g, bool ok0, bool chk0, MF0 valid0, bool ok1, bool chk1, MF1 valid1) {
    const bool first0 = (st0.m == NEG_INF), first1 = (st1.m == NEG_INF);
    const float cm0 = ok0 ? (first0 ? 0.f : -st0.m) : NEG_INF, cm1 = ok1 ? (first1 ? 0.f : -st1.m) : NEG_INF;
    const f32x4 c0 = (f32x4){cm0, cm0, cm0, cm0}, c1 = (f32x4){cm1, cm1, cm1, cm1};
    f32x4 s0[4], s1[4];
#pragma unroll
    for (int ni = 0; ni < 4; ++ni) {
        s0[ni] = c0; s1[ni] = c1;
#pragma unroll
        for (int ks = 0; ks < 2; ++ks) {
            const bf16x8 kf = *(const bf16x8*)(sK + (ni >> 1) * 4096 + (ni & 1) * 512 + (fb.kb ^ ((ni & 1) * 80) ^ (ks * 64)));
            s0[ni] = __builtin_amdgcn_mfma_f32_16x16x32_bf16(kf, q0[ks], s0[ni], 0, 0, 0);
            s1[ni] = __builtin_amdgcn_mfma_f32_16x16x32_bf16(kf, q1[ks], s1[ni], 0, 0, 0);
        }
    }
    if (chk0) {
#pragma unroll
        for (int ni = 0; ni < 4; ++ni)
#pragma unroll
            for (int r = 0; r < 4; ++r) { if (!valid0(KEY_OF(ni, g, r))) s0[ni][r] = NEG_INF; }
    }
    if (chk1) {
#pragma unroll
        for (int ni = 0; ni < 4; ++ni)
#pragma unroll
            for (int r = 0; r < 4; ++r) { if (!valid1(KEY_OF(ni, g, r))) s1[ni][r] = NEG_INF; }
    }
    const float g0 = xr_max(max16m(s0)), g1 = xr_max(max16m(s1));
    if (__any((first0 ? (g0 > NEG_INF) : (g0 > RESCALE_THR)) || (first1 ? (g1 > NEG_INF) : (g1 > RESCALE_THR)))) {
        const float sh0 = (g0 == NEG_INF) ? 0.f : (first0 ? g0 : fmaxf(g0, 0.f)), sh1 = (g1 == NEG_INF) ? 0.f : (first1 ? g1 : fmaxf(g1, 0.f));
        const float alpha0 = first0 ? 1.f : EXP2(-sh0), alpha1 = first1 ? 1.f : EXP2(-sh1);
        st0.m = (g0 == NEG_INF) ? st0.m : (first0 ? 0.f : st0.m) + sh0; st1.m = (g1 == NEG_INF) ? st1.m : (first1 ? 0.f : st1.m) + sh1;
        const f32x4 nsh0 = (f32x4){-sh0, -sh0, -sh0, -sh0}, nsh1 = (f32x4){-sh1, -sh1, -sh1, -sh1};
#pragma unroll
        for (int ni = 0; ni < 4; ++ni) { s0[ni] = s0[ni] + nsh0; s1[ni] = s1[ni] + nsh1; }
        st0.l *= alpha0; st1.l *= alpha1;
#pragma unroll
        for (int mi = 0; mi < 4; ++mi) { st0.o[mi] *= alpha0; st1.o[mi] *= alpha1; }
    }
    f32x4 a0 = (f32x4){0.f, 0.f, 0.f, 0.f}, a1 = a0;
#pragma unroll
    for (int ni = 0; ni < 4; ++ni) {
#pragma unroll
        for (int r = 0; r < 4; ++r) { s0[ni][r] = EXP2(s0[ni][r]); s1[ni][r] = EXP2(s1[ni][r]); }
        a0 += s0[ni]; a1 += s1[ni];
    }
    st0.l += xr_sum((a0[0] + a0[1]) + (a0[2] + a0[3])); st1.l += xr_sum((a1[0] + a1[1]) + (a1[2] + a1[3]));
    bf16x8 pf0[2], pf1[2];
    p_pack(pf0, s0); p_pack(pf1, s1);
    bf16x8 vf[2][4];
#pragma unroll
    for (int kk = 0; kk < 2; ++kk)
#pragma unroll
        for (int mi = 0; mi < 4; ++mi) vf[kk][mi] = *(const bf16x8*)(sV + mi * 2048 + (fb.vb ^ (((kk ^ mi) & 1) << 6)));
#pragma unroll
    for (int kk = 0; kk < 2; ++kk)
#pragma unroll
        for (int mi = 0; mi < 4; ++mi) {
            st0.o[mi] = __builtin_amdgcn_mfma_f32_16x16x32_bf16(vf[kk][mi], pf0[kk], st0.o[mi], 0, 0, 0);
            st1.o[mi] = __builtin_amdgcn_mfma_f32_16x16x32_bf16(vf[kk][mi], pf1[kk], st1.o[mi], 0, 0, 0);
        }
}
template <class NF, class TF, class MF0, class MF1>
__device__ __forceinline__ void attn_run_g2(const int t, AttnState& st0, AttnState& st1, unsigned char* ring, const bf16_t* kbase, long kld, const bf16_t* vtbase, long vld,
                                            const bf16x8 (&q0)[2], const bf16x8 (&q1)[2], int fr, int g, NF next, TF tinfo, MF0 mask0, MF1 mask1) {
    const int lane = t & 63, wid = __builtin_amdgcn_readfirstlane(t >> 6);
    unsigned ko[2], vo[2];
#pragma unroll
    for (int j = 0; j < 2; ++j) { const int row = 8 * (wid * 2 + j) + (lane >> 3); const int c = ((lane & 7) ^ ((row >> 2) ^ row)) & 7;
        ko[j] = (unsigned)(row * kld + c * 8); vo[j] = (unsigned)(row * vld + c * 8); }
    auto issue = [&](int kt, int stage) {
        unsigned char* sK = ring + stage * 16384 + wid * 2048; unsigned char* sV = sK + 8192;
        const bf16_t* kb = kbase + (long)kt * 64 * kld; const bf16_t* vb = vtbase + (long)kt * 64;
#pragma unroll
        for (int j = 0; j < 2; ++j) { glds16(kb + ko[j], sK + j * 1024); glds16(vb + vo[j], sV + j * 1024); }
    };
    const FragBase fb = frag_base(fr, g);
    int kA = __builtin_amdgcn_readfirstlane(next(-1)), kB = (kA >= 0) ? __builtin_amdgcn_readfirstlane(next(kA)) : -1;
    if (kA >= 0) issue(kA, 0);
    if (kB >= 0) issue(kB, 1);
    int i = 0;
    while (kA >= 0) {
        const int kC = (kB >= 0) ? __builtin_amdgcn_readfirstlane(next(kB)) : -1, kD = (kC >= 0) ? __builtin_amdgcn_readfirstlane(next(kC)) : -1;
        asm volatile("s_waitcnt vmcnt(0)" ::: "memory");
        asm volatile("s_waitcnt lgkmcnt(0)" ::: "memory"); __builtin_amdgcn_s_barrier(); asm volatile("" ::: "memory");
        const int sb = (i & 1) * 2;
        if (kC >= 0) issue(kC, sb ^ 2);
        if (kD >= 0) issue(kD, (sb ^ 2) + 1);
        const unsigned char* sKa = ring + sb * 16384; const unsigned char* sKb = sKa + 16384;
        { bool ok0, chk0, ok1, chk1; tinfo(kA, ok0, chk0, ok1, chk1);
          attn_tile_g2(st0, st1, sKa, sKa + 8192, q0, q1, fb, g, ok0, chk0, [&](int kl) { return mask0(kA, kl); }, ok1, chk1, [&](int kl) { return mask1(kA, kl); }); }
        if (kB >= 0) { bool ok0, chk0, ok1, chk1; tinfo(kB, ok0, chk0, ok1, chk1);
          attn_tile_g2(st0, st1, sKb, sKb + 8192, q0, q1, fb, g, ok0, chk0, [&](int kl) { return mask0(kB, kl); }, ok1, chk1, [&](int kl) { return mask1(kB, kl); }); }
        kA = kC; kB = kD; ++i;
    }
    asm volatile("s_waitcnt lgkmcnt(0)" ::: "memory"); __builtin_amdgcn_s_barrier(); asm volatile("" ::: "memory");
}

__device__ __forceinline__ unsigned units_in(int bid, int G, int lo, int hi) {
    const int a = lo > bid ? (lo - bid + G - 1) / G : 0, b = hi > bid ? (hi - bid + G - 1) / G : 0; return (unsigned)(b - a); }

__global__ void __launch_bounds__(256, 2) fwd_kernel(Params p) {
    extern __shared__ __attribute__((aligned(16))) unsigned char smem[];
    const int G = gridDim.x;
    volatile LAS unsigned* xbw = (volatile LAS unsigned*)(smem + SMEM_BYTES - 16);
    if (threadIdx.x == 0) { xbw[0] = 0u; xbw[1] = 0u; xbw[2] = 0u; xbw[3] = 0u; }
    __syncthreads();
    (void)xcd_barrier_post((unsigned*)(p.ws + WS_BAR), xbw);
    const int wid_s = __builtin_amdgcn_readfirstlane((int)(threadIdx.x >> 6));
#define GRID_BARRIER() do { XcdBarrier b_; b_.bar = (unsigned*)(p.ws + WS_BAR); b_.x = xb_xcc_id(); b_.st = (volatile LAS unsigned*)(smem + SMEM_BYTES - 16); xcd_barrier(b_); } while (0)
#define PHASE_BEGIN int t; asm volatile("v_mbcnt_lo_u32_b32 %0, -1, 0\n\tv_mbcnt_hi_u32_b32 %0, -1, %0" : "=v"(t)); t += wid_s * 64; asm volatile("" : "+v"(t)); \
                    const int lane = t & 63, wid = wid_s; (void)lane; (void)wid; \
                    int bid = (int)blockIdx.x; asm volatile("" : "+s"(bid)); size_t wso_ = 0; asm volatile("" : "+s"(wso_)); unsigned char* ws = p.ws + wso_;
#define Q_NEXT(ctr_, var_) { __syncthreads(); if (t == 0) *(volatile int*)(smem + SMEM_BYTES - 32) = (int)atomicAdd((ctr_), 1u); __syncthreads(); var_ = __builtin_amdgcn_readfirstlane(*(volatile int*)(smem + SMEM_BYTES - 32)); }
#define FLAG_PUBLISH(flag_, n_) do { asm volatile("s_waitcnt vmcnt(0)" ::: "memory"); __syncthreads(); \
    if (t == 0) { __builtin_amdgcn_fence(__ATOMIC_RELEASE, "agent"); asm volatile("s_waitcnt vmcnt(0)" ::: "memory"); (void)xb_add((flag_), (n_)); } } while (0)
#define FLAG_WAIT(flag_, n_) do { if (t == 0) { unsigned* bar_ = (unsigned*)(p.ws + WS_BAR); unsigned* fl_ = (flag_); XB_SPIN(xb_ld(fl_) < (n_), bar_); \
    __builtin_amdgcn_fence(__ATOMIC_ACQUIRE, "agent"); asm volatile("s_waitcnt vmcnt(0)" ::: "memory"); } __syncthreads(); } while (0)
#define XPUB_WORD(L_, pt_) ((unsigned*)(p.ws + WS_QCTR + 8192 + (((size_t)(L_) * 4 + (pt_)) * 16 + xb_xcc_id()) * 64))
#define XCD_ARRIVE(L_, pt_, inc_, onlast_) do { asm volatile("s_waitcnt vmcnt(0)" ::: "memory"); __syncthreads(); \
    if (t == 0) { const unsigned nloc_ = *(volatile LAS unsigned*)(smem + SMEM_BYTES - 16); const unsigned inc2_ = (1u << 24) | (inc_); \
        const unsigned tot_ = xb_add(XPUB_WORD(L_, pt_), inc2_) + inc2_; \
        if ((tot_ >> 24) == nloc_) { __builtin_amdgcn_fence(__ATOMIC_RELEASE, "agent"); asm volatile("s_waitcnt vmcnt(0)" ::: "memory"); onlast_; } } } while (0)
#define PHASE_BEGIN_L PHASE_BEGIN int Lx_ = Lrun; asm volatile("" : "+s"(Lx_)); const int L = Lx_; \
                    const float* xin = (L == 0) ? p.x : (const float*)xB; const float* modL = modb + (size_t)L * 2 * 6144; (void)xin; (void)modL;

    { PHASE_BEGIN
    for (int u = bid; u < 384 + 256 + 2 * 1344 + 32; u += G) {
        if (u >= 384 + 256 + 2 * 1344) {
            const int w = u - (384 + 256 + 2 * 1344), lk = w >> 3, ch = w & 7;
            const float* w1f = p.cmp_w1 + (size_t)lk * 2048 * 128; const float* pef = p.cmp_pe + (size_t)lk * 2048;
            float* red = (float*)smem;
            const int j = t & 127, hf = t >> 7; float s = 0.f;
#pragma unroll 8
            for (int k = ch * 256 + hf * 128; k < ch * 256 + hf * 128 + 128; ++k) s += pef[k] * w1f[(size_t)k * 128 + j];
            red[t] = s;
            __syncthreads();
            if (t < 128) pbias[(size_t)w * 128 + t] = red[t] + red[128 + t];
            __syncthreads();
        } else if (u >= 384 + 256) {
            const int w = u - 640, l = w / 1344; int r = w % 1344;
            const float* src; long ldn; int nval, kb, nb; bf16_t* dst; long dK;
            if (r < 704)       { kb = r / 44; nb = r % 44; src = p.w_in + (size_t)l * 1024 * INCOLS; ldn = INCOLS; nval = INCOLS; dst = WTL(l) + WT_IN; dK = 1024; }
            else if (r < 960)  { r -= 704; kb = r >> 4; nb = r & 15; src = p.w_out + (size_t)l * 1048576; ldn = 1024; nval = 1024; dst = WTL(l) + WT_OUT; dK = 1024; }
            else if (r < 1024) { r -= 960; kb = r >> 2; nb = r & 3; src = p.w_router + (size_t)l * 262144; ldn = 256; nval = 256; dst = WTL(l) + WT_R; dK = 1024; }
            else if (r < 1088) { r -= 1024; kb = r >> 2; nb = r & 3; src = p.sh_gate + (size_t)l * 262144; ldn = 256; nval = 256; dst = WTL(l) + WT_SGU; dK = 1024; }
            else if (r < 1152) { r -= 1088; kb = r >> 2; nb = r & 3; src = p.sh_up + (size_t)l * 262144; ldn = 256; nval = 256; dst = WTL(l) + WT_SGU + 262144; dK = 1024; }
            else if (r < 1216) { r -= 1152; kb = r >> 4; nb = r & 15; src = p.sh_down + (size_t)l * 262144; ldn = 1024; nval = 1024; dst = WTL(l) + WT_SD; dK = 256; }
            else               { r -= 1216; const int kv = r >> 6; r &= 63; kb = r >> 1; nb = r & 1; src = p.cmp_w1 + ((size_t)l * 2 + kv) * 262144; ldn = 128; nval = 128; dst = WTL(l) + WT_W1 + (size_t)kv * 262144; dK = 2048; }
            int nv = nval - nb * 64; nv = nv < 0 ? 0 : (nv > 64 ? 64 : nv);
            conv_block(src + (size_t)kb * 64 * ldn + nb * 64, ldn, nv, dst + (size_t)nb * 64 * dK + kb * 64, dK, smem, t);
        } else if (u < 384) {
            const int l = u / 192, j0 = (u % 192) * 32;
            float* sc = (float*)smem;
            float* red = sc + 2048;
            for (int i = t; i < 2048; i += 256) sc[i] = siluf_(p.c[i]);
            __syncthreads();
            const int c = t & 31, rg = t >> 5;
            const float* w = p.w_ada + (size_t)l * 1024 * 6144 + j0 + c;
            float s0 = 0.f, s1 = 0.f;
#pragma unroll 8
            for (int i = rg * 128; i < rg * 128 + 128; ++i) { const float wv = w[(size_t)i * 6144]; s0 += sc[i] * wv; s1 += sc[1024 + i] * wv; }
            red[(rg * 32 + c) * 2] = s0; red[(rg * 32 + c) * 2 + 1] = s1;
            __syncthreads();
            if (t < 64) {
                const int cc = t & 31, b = t >> 5;
                float s = 0.f;
                for (int r = 0; r < 8; ++r) s += red[(r * 32 + cc) * 2 + b];
                modb[(l * 2 + b) * 6144 + j0 + cc] = s + p.b_ada[l * 6144 + j0 + cc];
            }
            __syncthreads();
        } else {
            const int idx = (u - 384) * 256 + t, pos = idx >> 3, i = idx & 7;
            const float inv = powf(500000.0f, -(float)i / 8.0f);
            const float ang = (float)pos * inv;
            float sn, cs; sincosf(ang, &sn, &cs);
            rope[idx] = make_float2(cs, sn);
        }
    }
    }
    GRID_BARRIER();

    { PHASE_BEGIN
        const float4* x4 = (const float4*)p.x;
        for (long i = (long)bid * 256 + t; i < (long)NTOK * 256; i += (long)G * 256) {
            const int tok = (int)(i >> 8), d = (int)(i & 255) * 4, b = tok >> 13;
            const float4 xv = x4[i];
            const float4 sh = *(const float4*)(modb + (0 * 2 + b) * 6144 + d), sc = *(const float4*)(modb + (0 * 2 + b) * 6144 + 1024 + d);
            uint2 o; o.x = pack2(xv.x * (1.f + sc.x) + sh.x, xv.y * (1.f + sc.y) + sh.y); o.y = pack2(xv.z * (1.f + sc.z) + sh.z, xv.w * (1.f + sc.w) + sh.w);
            *(uint2*)(hbuf + (size_t)tok * 1024 + d) = o;
        }
    }
    GRID_BARRIER();

    for (int Lrun = 0; Lrun < NLAYER; ++Lrun) {

        { PHASE_BEGIN_L
            const bf16_t* W = WTL(L) + WT_IN;
            for (int u = bid; u < 128 * 22; u += G) {
                const int mt = u / 22, nt = u % 22, row0 = mt * 128, n0 = nt * 128;
                gemm_dma<128, 2>(smem, t, 16, hbuf + (size_t)row0 * 1024, [&](int r) { return (unsigned)(r * 1024); }, 64,
                    W + (size_t)n0 * 1024, [&](int r) { return (unsigned)(r * 1024); },
                    [&](f32x4 (&acc)[4][4], int wr, int wc, int fr, int g) {
#pragma unroll
                        for (int m = 0; m < 4; ++m) {
                            const int tok = row0 + wr * 64 + m * 16 + fr, b = tok >> 13, pos = tok & 8191;
#pragma unroll
                            for (int n = 0; n < 4; ++n) {
                                const int c16 = n0 + wc * 64 + n * 16;
                                if (c16 >= INCOLS) continue;
                                const int c0 = c16 + 4 * g;
                                f32x4 v = acc[m][n];
                                const bool ropeseg = (c16 < 512) || (c16 >= 768 && c16 < 1024) || (c16 >= 1152 && c16 < 1216) || (c16 >= 1280 && c16 < 1344);
                                f32x4 vr = v;
                                if (ropeseg && ((c16 & 63) == 0)) {
#pragma unroll
                                    for (int r = 0; r < 4; ++r) {
                                        const float other = __shfl_xor(v[r], 32);
                                        const float2 cs = rope[pos * 8 + ((4 * g + r) & 7)];
                                        vr[r] = (g < 2) ? (v[r] * cs.x - other * cs.y) : (other * cs.y + v[r] * cs.x);
                                    }
                                }
                                if (c0 >= INCOLS) continue;
                                if (c16 < 256) { vr *= 0.18033688f; }
                                else if (c16 >= 768 && c16 < 1024) { v *= 0.18033688f; vr *= 0.18033688f; }
                                else if (c0 >= 1676 && c0 < 1932) { vr *= 0.125f; }
                                uint2 o; o.x = pack2(vr[0], vr[1]); o.y = pack2(vr[2], vr[3]);
                                if (c16 >= 512 && c16 < 768) {
                                    const int hh = (c0 - 512) >> 6, dd = (c0 - 512) & 63;
                                    bf16_t* dst = vtm + ((size_t)(b * 4 + hh) * 64 + dd) * 8192 + pos;
                                    dst[0] = (bf16_t)(o.x & 0xffff); dst[8192] = (bf16_t)(o.x >> 16); dst[2 * 8192] = (bf16_t)(o.y & 0xffff); dst[3 * 8192] = (bf16_t)(o.y >> 16);
                                } else if (c16 >= 1216 && c16 < 1280) {
                                    const int dd = c0 - 1216;
                                    bf16_t* dst = vts + ((size_t)b * 64 + dd) * 8192 + pos;
                                    dst[0] = (bf16_t)(o.x & 0xffff); dst[8192] = (bf16_t)(o.x >> 16); dst[2 * 8192] = (bf16_t)(o.y & 0xffff); dst[3 * 8192] = (bf16_t)(o.y >> 16);
                                } else if (c16 >= 1344 && c16 < 1408) {
                                    const int dd = c0 - 1344;
                                    bf16_t* dst = vtw + ((size_t)b * 64 + dd) * 8192 + pos;
                                    dst[0] = (bf16_t)(o.x & 0xffff); dst[8192] = (bf16_t)(o.x >> 16); dst[2 * 8192] = (bf16_t)(o.y & 0xffff); dst[3 * 8192] = (bf16_t)(o.y >> 16);
                                } else if (c16 >= 768 && c16 < 1024) {
                                    uint2 oraw; oraw.x = pack2(v[0], v[1]); oraw.y = pack2(v[2], v[3]);
                                    *(uint2*)(zb + (size_t)tok * ZLD + c0) = oraw;
                                    *(uint2*)(qrot + (size_t)tok * 256 + (c0 - 768)) = o;
                                } else {
                                    const int zc = c0 + (c0 >= 1420 ? 4 : 0);
                                    *(uint2*)(zb + (size_t)tok * ZLD + zc) = o;
                                }
                            }
                        }
                    });
            }
        }
        GRID_BARRIER();

        { PHASE_BEGIN_L
            const int NB2 = 128;
            for (int u = bid; u < NB2; u += G) {
                {
                    const int kv = u >> 6, rt = (u >> 3) & 7, ks = u & 7;
                    const bf16_t* w1 = WTL(L) + WT_W1 + (size_t)kv * 128 * 2048 + ks * 256;
                    const int zcol = kv ? Z_VC : Z_KC;
                    float* dstp = cpart + ((size_t)(ks * 2 + kv) * 1024 + rt * 128) * 128;
                    gemm_dma<128, 2>(smem, t, 4, zb + zcol + (size_t)ks * 4 * ZLD,
                        [&](int r) { const int R = rt * 128 + r; if (R >= 1022) return 0u; const int b = R / 511, n = R % 511;
                                     return (unsigned)((b * 8192 + 16 * n) * ZLD); }, ZLD,
                        w1, [&](int r) { return (unsigned)(r * 2048); },
                        [&](f32x4 (&acc)[4][4], int wr, int wc, int fr, int g) {
#pragma unroll
                            for (int m = 0; m < 4; ++m)
#pragma unroll
                                for (int n = 0; n < 4; ++n) {
                                    const int row = wr * 64 + m * 16 + fr, col = wc * 64 + n * 16 + 4 * g;
                                    *(float4*)(dstp + row * 128 + col) = make_float4(acc[m][n][0], acc[m][n][1], acc[m][n][2], acc[m][n][3]);
                                }
                        });
                }
            }
        }
        { PHASE_BEGIN_L
            const int NB2 = 128, NB1 = 256;
            for (int u = bid; u < NB2 + NB1; u += G) {
                if (u < NB2) continue;
                {
                    const int v = u - NB2, b = v >> 7, h = (v >> 5) & 3, blk = v & 31;
                    float* red = (float*)smem;
                    const int d = t & 63, rg = t >> 6;
                    const bf16_t* src = zb + ((size_t)b * 8192 + blk * 256 + rg * 64) * ZLD + Z_MK + h * 64 + d;
                    float s = 0.f;
                    for (int i = 0; i < 64; ++i) s += bf2f(src[(size_t)i * ZLD]);
                    red[rg * 64 + d] = s;
                    __syncthreads();
                    if (t < 64) kmean[((size_t)(b * 4 + h) * 32 + blk) * 64 + t] = (red[t] + red[64 + t] + red[128 + t] + red[192 + t]) * (1.f / 256.f);
                    __syncthreads();
                }
            }
            { const unsigned n1 = units_in(bid, G, NB2, NB2 + NB1); XCD_ARRIVE(L, 0, n1, (void)xb_add(QCTR(L, 6), tot_ & 0xffffffu)); }
        }
        { PHASE_BEGIN_L
            const int NB2 = 128, NB1 = 256, NB3 = 1024;
            for (int u = bid; u < NB2 + NB1 + NB3; u += G) {
                if (u < NB2 + NB1) continue;
                {
                    const int v = u - NB2 - NB1, b = v >> 9, h = (v >> 7) & 3, c = v & 127;
                    const size_t tok0 = (size_t)b * 8192 + c * 64;
                    float* la = (float*)smem;
                    float* ke = la + 4096;
                    float* vv = ke + 4096;
                    float* wa = vv + 4096;
                    float* ga = wa + 1024;
                    const float* gwa = p.gla_wa + (size_t)L * 16 * 256, *gba = p.gla_ba + (size_t)L * 256;
                    for (int i = t; i < 1024; i += 256) { const int r = i >> 6, d = i & 63; wa[i] = gwa[r * 256 + h * 64 + d]; }
                    for (int i = t; i < 1024; i += 256) { const int r = i >> 4, k = i & 15; ga[i] = bf2f(zb[(tok0 + r) * ZLD + Z_GA + k]); }
                    __syncthreads();
                    {
                        const int d = t & 63, ig = t >> 6;
                        const float bias = gba[h * 64 + d];
                        for (int i = ig * 16; i < ig * 16 + 16; ++i) {
                            float s = bias;
#pragma unroll
                            for (int k = 0; k < 16; ++k) s += ga[i * 16 + k] * wa[k * 64 + d];
                            const float ls = fminf(s, 0.f) - log1pf(__expf(-fabsf(s)));
                            la[i * 64 + d] = ls * (1.f / 16.f);
                        }
                    }
                    __syncthreads();
                    if (t < 64) { float run = 0.f; for (int i = 0; i < 64; ++i) { run += la[i * 64 + t]; la[i * 64 + t] = run; } }
                    __syncthreads();
                    for (int i = t; i < 4096; i += 256) {
                        const int j = i >> 6, d = i & 63;
                        const float bj = la[i], be = la[63 * 64 + d];
                        bcum[(tok0 + j) * 256 + h * 64 + d] = bj;
                        ke[i] = bf2f(zb[(tok0 + j) * ZLD + Z_GK + h * 64 + d]) * __expf(be - bj);
                        vv[i] = bf2f(zb[(tok0 + j) * ZLD + Z_GV + h * 64 + d]);
                    }
                    if (t < 64) aend[((size_t)(b * 4 + h) * 128 + c) * 64 + t] = __expf(la[63 * 64 + t]);
                    __syncthreads();
                    {
                        const int fr = lane & 15, g = lane >> 4;
                        f32x4 ua[4];
#pragma unroll
                        for (int n = 0; n < 4; ++n) ua[n] = (f32x4){0.f, 0.f, 0.f, 0.f};
                        for (int j0 = 0; j0 < 64; j0 += 4) {
                            const float a = ke[(j0 + g) * 64 + 16 * wid + fr];
#pragma unroll
                            for (int n = 0; n < 4; ++n) ua[n] = __builtin_amdgcn_mfma_f32_16x16x4f32(a, vv[(j0 + g) * 64 + 16 * n + fr], ua[n], 0, 0, 0);
                        }
                        float* dst = Ub + ((size_t)(b * 4 + h) * 128 + c) * 4096;
#pragma unroll
                        for (int n = 0; n < 4; ++n)
#pragma unroll
                            for (int r = 0; r < 4; ++r) dst[(16 * wid + 4 * g + r) * 64 + 16 * n + fr] = ua[n][r];
                    }
                    __syncthreads();
                }
            }
        }
        { PHASE_BEGIN_L
            const int NB2 = 128, NB1 = 256, NB3 = 1024, NB4 = 1024;
            for (int u = bid; u < NB2 + NB1 + NB3 + NB4; u += G) {
                if (u < NB2 + NB1 + NB3) continue;
                {
                    const int v = u - NB2 - NB1 - NB3, tok0 = v * 16, b = tok0 >> 13, pos0 = tok0 & 8191;
                    float* ul = (float*)smem;
                    float* pl = ul + 31 * 256;
                    for (int i = t; i < 31 * 256; i += 256) {
                        const int r = i >> 8, cidx = i & 255, pos = pos0 - 15 + r;
                        ul[i] = (pos >= 0) ? bf2f(zb[((size_t)b * 8192 + pos) * ZLD + Z_POOL + cidx]) : 0.f;
                    }
                    __syncthreads();
                    {
                        const int cidx = t, gq = cidx >> 6, w = 2 << gq;
                        for (int r = 0; r < 16; ++r) {
                            const int pos = pos0 + r;
                            float s = 0.f;
                            for (int k = 0; k < w; ++k) s += ul[(15 + r - k) * 256 + cidx];
                            const float cnt = (float)((pos + 1 < w) ? (pos + 1) : w);
                            pl[r * 256 + cidx] = s / cnt - ul[(15 + r) * 256 + cidx];
                        }
                    }
                    __syncthreads();
                    {
                        const int gq = t >> 6, d = t & 63;
                        const float* pw = p.pool_w + ((size_t)L * 4 + gq) * 4096;
                        float o[16];
#pragma unroll
                        for (int r = 0; r < 16; ++r) o[r] = 0.f;
                        for (int cc = 0; cc < 64; ++cc) {
                            const float wv = pw[cc * 64 + d];
#pragma unroll
                            for (int r = 0; r < 16; ++r) o[r] += pl[r * 256 + gq * 64 + cc] * wv;
                        }
                        const float ps = p.pool_scale[(size_t)L * 256 + t];
#pragma unroll
                        for (int r = 0; r < 16; ++r) ocat[(size_t)(tok0 + r) * 1024 + 512 + t] = f2bf(o[r] * ps);
                    }
                    __syncthreads();
                }
            }
            {
                const unsigned n2 = units_in(bid, G, 0, NB2), n3 = units_in(bid, G, NB2 + NB1, NB2 + NB1 + NB3);
                XCD_ARRIVE(L, 1, n2 | (n3 << 8), { (void)xb_add(QCTR(L, 7), tot_ & 0xffu); (void)xb_add(QCTR(L, 8), (tot_ >> 8) & 0xffffu); });
            }
        }

        { PHASE_BEGIN_L
            unsigned ndone = 0u;
            if (bid < 16) FLAG_WAIT(QCTR(L, 7), 128u);
            for (int u = bid; u < 16; u += G) {
                ++ndone;
                const int kv = u >> 3, rt = u & 7;
                const float* w2 = p.cmp_w2 + ((size_t)L * 2 + kv) * 128 * 64;
                bf16_t* hl = (bf16_t*)smem;
                float* pb = (float*)(smem + 32768);
                if (t < 128) { float s = 0.f; for (int c = 0; c < 8; ++c) s += pbias[((size_t)(L * 2 + kv) * 8 + c) * 128 + t]; pb[256 + t] = s; }
                __syncthreads();
                for (int i = t; i < 128 * 32; i += 256) {
                    const int row = i >> 5, c4 = (i & 31) * 4;
                    float4 a = make_float4(0.f, 0.f, 0.f, 0.f);
#pragma unroll
                    for (int ks = 0; ks < 8; ++ks) { const float4 pv = *(const float4*)(cpart + ((size_t)(ks * 2 + kv) * 1024 + rt * 128 + row) * 128 + c4); a.x += pv.x; a.y += pv.y; a.z += pv.z; a.w += pv.w; }
                    const float xs[4] = {a.x + pb[256 + c4], a.y + pb[256 + c4 + 1], a.z + pb[256 + c4 + 2], a.w + pb[256 + c4 + 3]}; float h4[4];
#pragma unroll
                    for (int r = 0; r < 4; ++r) { const float xx = xs[r]; const float u3 = 0.7978845608f * (xx + 0.044715f * xx * xx * xx); h4[r] = 0.5f * xx * (1.f + tanhf(u3)); }
                    uint2 o; o.x = pack2(h4[0], h4[1]); o.y = pack2(h4[2], h4[3]);
                    *(uint2*)(hl + row * 128 + c4) = o;
                }
                __syncthreads();
                {
                    const int d = t & 63, rg = t >> 6;
                    float o[32];
#pragma unroll
                    for (int r = 0; r < 32; ++r) o[r] = 0.f;
                    for (int j = 0; j < 128; ++j) {
                        const float wv = w2[j * 64 + d];
#pragma unroll
                        for (int r = 0; r < 32; ++r) o[r] += bf2f(hl[(rg * 32 + r) * 128 + j]) * wv;
                    }
#pragma unroll
                    for (int r = 0; r < 32; ++r) {
                        const int R = rt * 128 + rg * 32 + r;
                        int b, n; float val = o[r];
                        if (R < 1022) { b = R / 511; n = R % 511; } else { b = R - 1022; n = 511; val = 0.f; }
                        if (kv == 0) kcb[((size_t)b * 512 + n) * 64 + d] = f2bf(val);
                        else vct[((size_t)b * 64 + d) * 512 + n] = f2bf(val);
                    }
                }
                __syncthreads();
            }
            XCD_ARRIVE(L, 2, ndone, (void)xb_add(QCTR(L, 4), tot_ & 0xffffffu));
        }
        { PHASE_BEGIN_L
            const int NC1 = 128;
            unsigned ndone = 0u;
            if ((bid + G - 16) % G < NC1) FLAG_WAIT(QCTR(L, 8), 1024u);
            for (int u = (bid + G - 16) % G; u < NC1; u += G) {
                ++ndone;
                {
                    const int bh = u >> 4, e0 = (u & 15) * 256 + t, d = e0 >> 6;
                    float* Up = Ub + (size_t)bh * 128 * 4096 + e0;
                    const float* ap = aend + (size_t)bh * 128 * 64 + d;
                    float S = 0.f;
                    for (int c0 = 0; c0 < 128; c0 += 8) {
                        float uu[8], aa[8];
#pragma unroll
                        for (int k = 0; k < 8; ++k) { uu[k] = Up[(size_t)(c0 + k) * 4096]; aa[k] = ap[(c0 + k) * 64]; }
#pragma unroll
                        for (int k = 0; k < 8; ++k) { Up[(size_t)(c0 + k) * 4096] = S; S = aa[k] * S + uu[k]; }
                    }
                }
            }
            XCD_ARRIVE(L, 3, ndone, (void)xb_add(QCTR(L, 5), tot_ & 0xffffffu));
        }
        { PHASE_BEGIN_L
            FLAG_WAIT(QCTR(L, 6), 256u);
            unsigned* qc = QCTR(L, 1);
            for (;;) {
                int v; Q_NEXT(qc, v);
                if (v >= 512) break;
                {
                    const int qt = 63 - (v >> 3), b = (v >> 2) & 1, h = v & 3, t0 = qt * 128, own = t0 >> 8;
                    float* qs = (float*)smem;
                    float* km = qs + 64 * 65;
                    float* gl = km + 32 * 64;
                    unsigned* selm = (unsigned*)(smem + 65536);
                    for (int j = 0; j < 2; ++j) {
                        {
                            const int qi = t >> 2, dp = (t & 3) * 16;
                            const bf16_t* src = zb + ((size_t)b * 8192 + t0 + j * 64 + qi) * ZLD + Z_MQ + h * 64 + dp;
                            const uint4 a0 = *(const uint4*)src, a1 = *(const uint4*)(src + 8);
                            float* dq = qs + qi * 65 + dp;
                            dq[0] = bflo(a0.x); dq[1] = bfhi(a0.x); dq[2] = bflo(a0.y); dq[3] = bfhi(a0.y); dq[4] = bflo(a0.z); dq[5] = bfhi(a0.z); dq[6] = bflo(a0.w); dq[7] = bfhi(a0.w);
                            dq[8] = bflo(a1.x); dq[9] = bfhi(a1.x); dq[10] = bflo(a1.y); dq[11] = bfhi(a1.y); dq[12] = bflo(a1.z); dq[13] = bfhi(a1.z); dq[14] = bflo(a1.w); dq[15] = bfhi(a1.w);
                            if (j == 0) for (int i = t; i < own * 64; i += 256) km[i] = kmean[(size_t)(b * 4 + h) * 2048 + i];
                        }
                        __syncthreads();
                        {
                            const int qi = t & 63, ngp = t >> 6;
                            for (int n = ngp * 8; n < ngp * 8 + 8; ++n) {
                                if (n < own) { float s = 0.f;
#pragma unroll 16
                                    for (int d = 0; d < 64; ++d) s += qs[qi * 65 + d] * km[n * 64 + d];
                                    gl[qi * 33 + n] = s; }
                            }
                        }
                        __syncthreads();
                        if (t < 64) {
                            float v1 = NEG_INF, v2 = NEG_INF, v3 = NEG_INF; int i1 = -1, i2 = -1, i3 = -1;
                            for (int n = 0; n < own; ++n) {
                                const float s = gl[t * 33 + n];
                                if (s > v1) { v3 = v2; i3 = i2; v2 = v1; i2 = i1; v1 = s; i1 = n; }
                                else if (s > v2) { v3 = v2; i3 = i2; v2 = s; i2 = n; }
                                else if (s > v3) { v3 = s; i3 = n; }
                            }
                            unsigned m = 0u; if (i1 >= 0) m |= 1u << i1; if (i2 >= 0) m |= 1u << i2; if (i3 >= 0) m |= 1u << i3;
                            selm[j * 64 + t] = m;
                            unsigned um = m;
#pragma unroll
                            for (int off = 32; off >= 1; off >>= 1) um |= __shfl_xor(um, off);
                            if (t == 0) selm[128 + j] = um;
                        }
                        __syncthreads();
                    }
                    {
                        const int fr = lane & 15, g = lane >> 4, qpos0 = t0 + wid * 16 + fr, qpos1 = qpos0 + 64;
                        const unsigned mysel0 = selm[wid * 16 + fr], mysel1 = selm[64 + wid * 16 + fr], um = (unsigned)__builtin_amdgcn_readfirstlane((int)(selm[128] | selm[129]));
                        const bf16_t* qp = zb + ((size_t)b * 8192 + qpos0) * ZLD + Z_MQ + h * 64;
                        bf16x8 q0[2], q1[2]; q0[0] = *(const bf16x8*)(qp + g * 8); q0[1] = *(const bf16x8*)(qp + 32 + g * 8);
                        q1[0] = *(const bf16x8*)(qp + (size_t)64 * ZLD + g * 8); q1[1] = *(const bf16x8*)(qp + (size_t)64 * ZLD + 32 + g * 8);
                        AttnState st0, st1; attn_init(st0); attn_init(st1);
                        const int kd0 = 2 * qt, ktmax = 2 * qt + 1;
                        attn_run_g2(t, st0, st1, smem, zb + (size_t)b * 8192 * ZLD + Z_MK + h * 64, ZLD, vtm + (size_t)(b * 4 + h) * 64 * 8192, 8192, q0, q1, fr, g,
                            [&](int kt) { for (int k = kt + 1; k <= ktmax; ++k) { const int blk = k >> 2; if (blk == own || ((um >> blk) & 1u)) return k; } return -1; },
                            [&](int kt, bool& ok0, bool& chk0, bool& ok1, bool& chk1) { const int blk = kt >> 2; const bool past = blk < own;
                                ok0 = past ? (((mysel0 >> blk) & 1u) != 0u) : (kt <= kd0); ok1 = past ? (((mysel1 >> blk) & 1u) != 0u) : true; chk0 = (kt == kd0); chk1 = (kt == ktmax); },
                            [&](int kt, int kl) { return kt * 64 + kl <= qpos0; },
                            [&](int kt, int kl) { return kt * 64 + kl <= qpos1; });
                        const float inv0 = 1.f / st0.l, inv1 = 1.f / st1.l;
                        bf16_t* dst = ocat + ((size_t)b * 8192 + qpos0) * 1024 + h * 64;
#pragma unroll
                        for (int mi = 0; mi < 4; ++mi) { uint2 o; o.x = pack2(st0.o[mi][0] * inv0, st0.o[mi][1] * inv0); o.y = pack2(st0.o[mi][2] * inv0, st0.o[mi][3] * inv0);
                            *(uint2*)(dst + mi * 16 + 4 * g) = o; }
#pragma unroll
                        for (int mi = 0; mi < 4; ++mi) { uint2 o; o.x = pack2(st1.o[mi][0] * inv1, st1.o[mi][1] * inv1); o.y = pack2(st1.o[mi][2] * inv1, st1.o[mi][3] * inv1);
                            *(uint2*)(dst + (size_t)64 * 1024 + mi * 16 + 4 * g) = o; }
                    }
                    __syncthreads();
                }
            }
        }
        { PHASE_BEGIN_L
            FLAG_WAIT(QCTR(L, 4), 16u);
            unsigned* qc = QCTR(L, 2);
            for (;;) {
                int v; Q_NEXT(qc, v);
                if (v >= 1024) break;
                {
                    const int b = v & 1, qt = 511 - (v >> 1), t0 = qt * 16;
                    const int fr = lane & 15, g = lane >> 4, hd = wid, qpos = t0 + fr;
                    const size_t tok = (size_t)b * 8192 + qpos;
                    unsigned char* sK = smem; unsigned char* sV = smem + 8192;
                    float* impw = (float*)(smem + 16384);
                    float* scoreL = (float*)(smem + 16384 + 32768);
                    unsigned char* selb = smem + 65536 + 512;
                    unsigned* usel = (unsigned*)(selb + 256);
                    f32x4 outacc[4];
#pragma unroll
                    for (int mi = 0; mi < 4; ++mi) outacc[mi] = (f32x4){0.f, 0.f, 0.f, 0.f};
                    const bf16_t* gp = zb + tok * ZLD + Z_GATE + hd * 3;
                    const float g0 = sigmoidf_(bf2f(gp[0])), g1 = sigmoidf_(bf2f(gp[1])), g2 = sigmoidf_(bf2f(gp[2]));
                    {
                        const bf16_t* qp = zb + tok * ZLD + Z_NQ + hd * 64;
                        bf16x8 q[2]; q[0] = *(const bf16x8*)(qp + g * 8); q[1] = *(const bf16x8*)(qp + 32 + g * 8);
                        const int ktc = (t0 + 15 >= 31) ? (((t0 + 15 - 31) >> 4) >> 6) : -1;
                        const bf16_t* kb = kcb + (size_t)b * 512 * 64; const bf16_t* vb = vct + (size_t)b * 64 * 512;
                        const FragBase fb = frag_base(fr, g);
                        float mrun = NEG_INF, lrun = 0.f;
                        uint4 pk0 = make_uint4(0u, 0u, 0u, 0u), pk1 = pk0, pv0 = pk0, pv1 = pk0;
                        if (ktc >= 0) tile_ld(t, kb, 64, pk0, pk1);
                        for (int kt = 0; kt <= ktc; ++kt) {
                            tile_st(t, sK, pk0, pk1);
                            __syncthreads();
                            if (kt + 1 <= ktc) tile_ld(t, kb + (size_t)(kt + 1) * 64 * 64, 64, pk0, pk1);
                            f32x4 s[4]; qk_tile(s, sK, q, fb);
                            float mx = NEG_INF;
#pragma unroll
                            for (int ni = 0; ni < 4; ++ni)
#pragma unroll
                                for (int r = 0; r < 4; ++r) { const int n = kt * 64 + KEY_OF(ni, g, r); if (16 * n + 31 > qpos) s[ni][r] = NEG_INF; mx = fmaxf(mx, s[ni][r]); }
                            mx = xr_max(mx);
                            const float mnew = fmaxf(mrun, mx), muse = (mnew == NEG_INF) ? 0.f : mnew;
                            float ps = 0.f;
#pragma unroll
                            for (int ni = 0; ni < 4; ++ni)
#pragma unroll
                                for (int r = 0; r < 4; ++r) ps += EXP2(s[ni][r] - muse);
                            ps = xr_sum(ps);
                            lrun = lrun * EXP2(mrun - muse) + ps; mrun = mnew;
                            __syncthreads();
                        }
                        const float muse = (mrun == NEG_INF) ? 0.f : mrun, invl = (lrun > 0.f) ? 1.f / lrun : 0.f;
                        f32x4 oc[4], accN = (f32x4){0.f, 0.f, 0.f, 0.f};
#pragma unroll
                        for (int mi = 0; mi < 4; ++mi) oc[mi] = (f32x4){0.f, 0.f, 0.f, 0.f};
                        float* impr = impw + (hd * 16 + fr) * 128 + 4 * g;
                        if (ktc >= 0) { tile_ld(t, kb, 64, pk0, pk1); tile_ld(t, vb, 512, pv0, pv1); }
                        for (int kt = 0; kt <= ktc; ++kt) {
                            tile_st(t, sK, pk0, pk1); tile_st(t, sV, pv0, pv1);
                            __syncthreads();
                            if (kt + 1 <= ktc) { tile_ld(t, kb + (size_t)(kt + 1) * 64 * 64, 64, pk0, pk1); tile_ld(t, vb + (kt + 1) * 64, 512, pv0, pv1); }
                            f32x4 s[4]; qk_tile(s, sK, q, fb);
#pragma unroll
                            for (int ni = 0; ni < 4; ++ni)
#pragma unroll
                                for (int r = 0; r < 4; ++r) { const int n = kt * 64 + KEY_OF(ni, g, r); s[ni][r] = (16 * n + 31 <= qpos) ? EXP2(s[ni][r] - muse) * invl : 0.f; }
                            bf16x8 pf[2]; p_pack(pf, s);
                            pv_tile(oc, sV, pf, fb);
                            f32x4 accC = accN; accN = (f32x4){0.f, 0.f, 0.f, 0.f};
#pragma unroll
                            for (int dm = 0; dm < 2; ++dm) {
                                const int j = 16 * (kt + dm) + fr;
#pragma unroll
                                for (int kk = 0; kk < 2; ++kk) {
                                    bf16x8 of;
#pragma unroll
                                    for (int jj = 0; jj < 8; ++jj) {
                                        const int n = 64 * kt + 32 * kk + 8 * g + jj;
                                        of[jj] = (n >= 4 * j - 1 && n <= 4 * j + 3) ? (short)0x3F80 : (short)0;
                                    }
                                    if (dm == 0) accC = __builtin_amdgcn_mfma_f32_16x16x32_bf16(of, pf[kk], accC, 0, 0, 0);
                                    else accN = __builtin_amdgcn_mfma_f32_16x16x32_bf16(of, pf[kk], accN, 0, 0, 0);
                                }
                            }
                            *(float4*)(impr + 16 * kt) = make_float4(accC[0], accC[1], accC[2], accC[3]);
                            __syncthreads();
                        }
#pragma unroll
                        for (int mi = 0; mi < 8; ++mi) {
                            if (mi > ktc) { const float sc_ = (mi == ktc + 1) ? 1.f : 0.f; *(float4*)(impr + 16 * mi) = make_float4(accN[0] * sc_, accN[1] * sc_, accN[2] * sc_, accN[3] * sc_); }
                        }
#pragma unroll
                        for (int mi = 0; mi < 4; ++mi) outacc[mi] += oc[mi] * g0;
                    }
                    __syncthreads();
                    {
                        const int qi = t >> 4, jg = t & 15, qp2 = t0 + qi, cur = qp2 >> 6;
                        float sc[8];
#pragma unroll
                        for (int i = 0; i < 8; ++i) {
                            const int j = jg * 8 + i;
                            float s = impw[(0 * 16 + qi) * 128 + j] + impw[(1 * 16 + qi) * 128 + j] + impw[(2 * 16 + qi) * 128 + j] + impw[(3 * 16 + qi) * 128 + j];
                            const bool forced = (j == 0) || (j == cur) || (j == cur - 1);
                            const bool valid = (j <= cur);
                            s = valid ? (forced ? 1e9f : s) : NEG_INF;
                            sc[i] = s; scoreL[qi * 129 + j] = s;
                        }
                        __syncthreads();
                        int rank[8];
#pragma unroll
                        for (int i = 0; i < 8; ++i) rank[i] = 0;
                        for (int j2 = 0; j2 < 128; ++j2) {
                            const float s2 = scoreL[qi * 129 + j2];
#pragma unroll
                            for (int i = 0; i < 8; ++i) { const int j = jg * 8 + i; rank[i] += (s2 > sc[i] || (s2 == sc[i] && j2 < j)) ? 1 : 0; }
                        }
                        unsigned byte = 0u;
#pragma unroll
                        for (int i = 0; i < 8; ++i) if (rank[i] < 16 && (jg * 8 + i) <= cur) byte |= 1u << i;
                        selb[qi * 16 + jg] = (unsigned char)byte;
                        __syncthreads();
                        if (t < 4) { unsigned um = 0u; for (int q2 = 0; q2 < 16; ++q2) um |= ((const unsigned*)selb)[q2 * 4 + t]; usel[t] = um; }
                        __syncthreads();
                    }
                    {
                        const bf16_t* qp = qrot + tok * 256 + hd * 64;
                        bf16x8 q[2]; q[0] = *(const bf16x8*)(qp + g * 8); q[1] = *(const bf16x8*)(qp + 32 + g * 8);
                        const unsigned* myselp = (const unsigned*)selb + fr * 4;
                        const unsigned ms0 = myselp[0], ms1 = myselp[1], ms2 = myselp[2], ms3 = myselp[3];
                        const unsigned us0 = (unsigned)__builtin_amdgcn_readfirstlane((int)usel[0]), us1 = (unsigned)__builtin_amdgcn_readfirstlane((int)usel[1]),
                                       us2 = (unsigned)__builtin_amdgcn_readfirstlane((int)usel[2]), us3 = (unsigned)__builtin_amdgcn_readfirstlane((int)usel[3]);
                        const int ktmax = (t0 + 15) >> 6;
                        {
                            AttnState st; attn_init(st);
                            attn_run(t, st, smem, zb + (size_t)b * 8192 * ZLD + Z_KS, ZLD, vts + (size_t)b * 64 * 8192, 8192, q, fr, g,
                                [&](int kt) { for (int k = kt + 1; k <= ktmax; ++k) { const int wq = k >> 5; const unsigned uw = (wq == 0) ? us0 : (wq == 1) ? us1 : (wq == 2) ? us2 : us3;
                                                                  if ((uw >> (k & 31)) & 1u) return k; } return -1; },
                                [&](int kt, bool& ok, bool& chk) { const int wq = kt >> 5; const unsigned mw = (wq == 0) ? ms0 : (wq == 1) ? ms1 : (wq == 2) ? ms2 : ms3;
                                                                   ok = ((mw >> (kt & 31)) & 1u) != 0u; chk = (kt == ktmax); },
                                [&](int kt, int kl) { return kt * 64 + kl <= qpos; });
                            const float inv = (st.l > 0.f) ? 1.f / st.l : 0.f;
#pragma unroll
                            for (int mi = 0; mi < 4; ++mi) outacc[mi] += st.o[mi] * (g1 * inv);
                        }
                        {
                            AttnState st; attn_init(st);
                            const int ktmin = (t0 >= 511) ? ((t0 - 511) >> 6) : 0;
                            attn_run(t, st, smem, zb + (size_t)b * 8192 * ZLD + Z_KW, ZLD, vtw + (size_t)b * 64 * 8192, 8192, q, fr, g,
                                [&](int kt) { const int k = (kt < 0) ? ktmin : kt + 1; return (k <= ktmax) ? k : -1; },
                                [&](int kt, bool& ok, bool& chk) { ok = true; chk = !((kt * 64 > t0 + 15 - 512) && (kt * 64 + 63 <= t0)); },
                                [&](int kt, int kl) { const int key = kt * 64 + kl; return (key <= qpos) && (key > qpos - 512); });
                            const float inv = (st.l > 0.f) ? 1.f / st.l : 0.f;
#pragma unroll
                            for (int mi = 0; mi < 4; ++mi) outacc[mi] += st.o[mi] * (g2 * inv);
                        }
                    }
                    bf16_t* dst = ocat + tok * 1024 + 256 + hd * 64;
#pragma unroll
                    for (int mi = 0; mi < 4; ++mi) { uint2 o; o.x = pack2(outacc[mi][0], outacc[mi][1]); o.y = pack2(outacc[mi][2], outacc[mi][3]);
                        *(uint2*)(dst + mi * 16 + 4 * g) = o; }
                    __syncthreads();
                }
            }
        }
        { PHASE_BEGIN_L
            FLAG_WAIT(QCTR(L, 5), 128u);
            unsigned* qc = QCTR(L, 3);
            for (;;) {
                int u; Q_NEXT(qc, u);
                if (u >= 1024) break;
                const int b = u >> 9, h = (u >> 7) & 3, c = u & 127;
                const size_t tok0 = (size_t)b * 8192 + c * 64;
                float* qeT = (float*)smem;
                float* keT = qeT + 64 * 65;
                float* at = keT + 64 * 65;
                float* Sl = at + 64 * 65;
                for (int i = t; i < 4096; i += 256) {
                    const int r = i >> 6, d = i & 63;
                    const float bb = bcum[(tok0 + r) * 256 + h * 64 + d];
                    qeT[d * 65 + r] = bf2f(zb[(tok0 + r) * ZLD + Z_GQ + h * 64 + d]) * __expf(bb);
                    keT[d * 65 + r] = bf2f(zb[(tok0 + r) * ZLD + Z_GK + h * 64 + d]) * __expf(-bb);
                    Sl[i] = Ub[((size_t)(b * 4 + h) * 128 + c) * 4096 + i];
                }
                __syncthreads();
                const int fr = lane & 15, g = lane >> 4, i0 = 16 * wid;
                {
                    f32x4 aa[4];
#pragma unroll
                    for (int n = 0; n < 4; ++n) aa[n] = (f32x4){0.f, 0.f, 0.f, 0.f};
                    for (int d0 = 0; d0 < 64; d0 += 4) {
                        const float a = qeT[(d0 + g) * 65 + i0 + fr];
#pragma unroll
                        for (int n = 0; n < 4; ++n) aa[n] = __builtin_amdgcn_mfma_f32_16x16x4f32(a, keT[(d0 + g) * 65 + 16 * n + fr], aa[n], 0, 0, 0);
                    }
#pragma unroll
                    for (int n = 0; n < 4; ++n)
#pragma unroll
                        for (int r = 0; r < 4; ++r) { const int i = i0 + 4 * g + r, j = 16 * n + fr; at[i * 65 + j] = (j <= i) ? aa[n][r] : 0.f; }
                }
                __syncthreads();
                for (int i = t; i < 4096; i += 256) { const int r = i >> 6, d = i & 63; keT[i] = bf2f(zb[(tok0 + r) * ZLD + Z_GV + h * 64 + d]); }
                __syncthreads();
                {
                    f32x4 oa[4];
#pragma unroll
                    for (int n = 0; n < 4; ++n) oa[n] = (f32x4){0.f, 0.f, 0.f, 0.f};
                    for (int j0 = 0; j0 < i0 + 16; j0 += 4) {
                        const float a = at[(i0 + fr) * 65 + j0 + g];
#pragma unroll
                        for (int n = 0; n < 4; ++n) oa[n] = __builtin_amdgcn_mfma_f32_16x16x4f32(a, keT[(j0 + g) * 64 + 16 * n + fr], oa[n], 0, 0, 0);
                    }
                    for (int d0 = 0; d0 < 64; d0 += 4) {
                        const float a = qeT[(d0 + g) * 65 + i0 + fr];
#pragma unroll
                        for (int n = 0; n < 4; ++n) oa[n] = __builtin_amdgcn_mfma_f32_16x16x4f32(a, Sl[(d0 + g) * 64 + 16 * n + fr], oa[n], 0, 0, 0);
                    }
                    float gnv[4];
#pragma unroll
                    for (int n = 0; n < 4; ++n) gnv[n] = p.gla_norm[(size_t)L * 64 + 16 * n + fr];
#pragma unroll
                    for (int r = 0; r < 4; ++r) {
                        const int i = i0 + 4 * g + r;
                        float ss = oa[0][r] * oa[0][r] + oa[1][r] * oa[1][r] + oa[2][r] * oa[2][r] + oa[3][r] * oa[3][r];
                        ss += __shfl_xor(ss, 1); ss += __shfl_xor(ss, 2); ss += __shfl_xor(ss, 4); ss += __shfl_xor(ss, 8);
                        const float rs = rsqrtf(ss * (1.f / 64.f) + LN_EPS);
#pragma unroll
                        for (int n = 0; n < 4; ++n) {
                            const float gv = bf2f(zb[(tok0 + i) * ZLD + Z_GG + h * 64 + 16 * n + fr]);
                            ocat[(tok0 + i) * 1024 + 768 + h * 64 + 16 * n + fr] = f2bf(oa[n][r] * rs * gnv[n] * siluf_(gv));
                        }
                    }
                }
                __syncthreads();
            }
        }
        GRID_BARRIER();

        { PHASE_BEGIN_L
            const bf16_t* W = WTL(L) + WT_OUT;
            for (int u = bid; u < 64 * 8; u += G) {
                const int mt = u >> 3, nt = u & 7, row0 = mt * 256, n0 = nt * 128;
                gemm_dma256(smem, t, 32, ocat + (size_t)row0 * 1024, [&](int r) { return (unsigned)(r * 1024); },
                    W + (size_t)n0 * 1024, [&](int r) { return (unsigned)(r * 1024); },
                    [&](f32x4 (&acc)[4][8], int wr, int fr, int g) {
#pragma unroll
                        for (int m = 0; m < 4; ++m) {
                            const int tok = row0 + wr * 64 + m * 16 + fr, b = tok >> 13;
#pragma unroll
                            for (int n = 0; n < 8; ++n) {
                                const int col = n0 + n * 16 + 4 * g;
                                float4 xv;
                                if (L == 0) xv = *(const float4*)(p.x + (size_t)tok * 1024 + col);
                                else { const uint2 xr = *(const uint2*)(xBh + (size_t)tok * 1024 + col); xv = make_float4(bflo(xr.x), bfhi(xr.x), bflo(xr.y), bfhi(xr.y)); }
                                const float4 gm = *(const float4*)(modL + b * 6144 + 2048 + col);
                                uint2 o; o.x = pack2(ALPHA * xv.x + gm.x * acc[m][n][0], ALPHA * xv.y + gm.y * acc[m][n][1]);
                                o.y = pack2(ALPHA * xv.z + gm.z * acc[m][n][2], ALPHA * xv.w + gm.w * acc[m][n][3]);
                                *(uint2*)(r1h + (size_t)tok * 1024 + col) = o;
                            }
                        }
                    });
            }
        }
        GRID_BARRIER();

        { PHASE_BEGIN_L
            const float* lg = p.ln_g + ((size_t)L * 2 + 0) * 1024, *lb = p.ln_b + ((size_t)L * 2 + 0) * 1024;
            const bf16_t* Wr = WTL(L) + WT_R;
            const float* rb = p.router_bias + (size_t)L * 256;
            unsigned* cnt = cntb + L * 256 * CSTR;
            for (int u = bid; u < 512; u += G) {
                const int row0 = u * 32;
                for (int r = 0; r < 8; ++r) {
                    const int tok = row0 + wid * 8 + r, b = tok >> 13;
                    float4 v[4]; float s = 0.f;
#pragma unroll
                    for (int i = 0; i < 4; ++i) { const uint2 rr = *(const uint2*)(r1h + (size_t)tok * 1024 + i * 256 + lane * 4);
                        v[i] = make_float4(bflo(rr.x), bfhi(rr.x), bflo(rr.y), bfhi(rr.y)); s += v[i].x + v[i].y + v[i].z + v[i].w; }
                    s = wave_sum(s);
                    const float mu = s * (1.f / 1024.f);
                    float q = 0.f;
#pragma unroll
                    for (int i = 0; i < 4; ++i) { const float a = v[i].x - mu, bq = v[i].y - mu, c = v[i].z - mu, d = v[i].w - mu; q += a * a + bq * bq + c * c + d * d; }
                    q = wave_sum(q);
                    const float rs = rsqrtf(q * (1.f / 1024.f) + LN_EPS);
#pragma unroll
                    for (int i = 0; i < 4; ++i) {
                        const int d = i * 256 + lane * 4;
                        const float4 gg = *(const float4*)(lg + d), bb = *(const float4*)(lb + d);
                        const float4 sh = *(const float4*)(modL + b * 6144 + 3072 + d), sc = *(const float4*)(modL + b * 6144 + 4096 + d);
                        float4 o; o.x = (v[i].x - mu) * rs * gg.x + bb.x; o.y = (v[i].y - mu) * rs * gg.y + bb.y; o.z = (v[i].z - mu) * rs * gg.z + bb.z; o.w = (v[i].w - mu) * rs * gg.w + bb.w;
                        { uint2 xo2; xo2.x = pack2(o.x, o.y); xo2.y = pack2(o.z, o.w); *(uint2*)(xAh + (size_t)tok * 1024 + d) = xo2; }
                        const float h0 = o.x * (1.f + sc.x) + sh.x, h1 = o.y * (1.f + sc.y) + sh.y, h2v = o.z * (1.f + sc.z) + sh.z, h3 = o.w * (1.f + sc.w) + sh.w;
                        uint2 hh; hh.x = pack2(h0, h1); hh.y = pack2(h2v, h3);
                        *(uint2*)(hbuf + (size_t)tok * 1024 + d) = hh;
                        v[i] = make_float4(h0, h1, h2v, h3);
                    }
                    {
                        float am = 0.f;
#pragma unroll
                        for (int i = 0; i < 4; ++i) am = fmaxf(fmaxf(am, fmaxf(fabsf(v[i].x), fabsf(v[i].y))), fmaxf(fabsf(v[i].z), fabsf(v[i].w)));
                        am = fmaxf(am, dppf<0xB1>(am)); am = fmaxf(am, dppf<0x4E>(am)); am = fmaxf(am, dppf<0x141>(am)); am = fmaxf(am, dppf<0x140>(am));
                        am = xr_max(am);
                        unsigned eb = (__float_as_uint(am) >> 23) & 255u; eb = eb < 8u ? 8u : eb;
                        const float qs = __uint_as_float((261u - eb) << 23);
#pragma unroll
                        for (int i = 0; i < 4; ++i) {
                            int w8 = __builtin_amdgcn_cvt_pk_fp8_f32(v[i].x * qs, v[i].y * qs, 0, false);
                            w8 = __builtin_amdgcn_cvt_pk_fp8_f32(v[i].z * qs, v[i].w * qs, w8, true);
                            *(unsigned*)(hb8 + (size_t)tok * 1024 + i * 256 + lane * 4) = (unsigned)w8;
                        }
                        if (lane == 0) hscl8[tok] = (unsigned char)eb;
                    }
                }
                __syncthreads();
                for (int nt = 0; nt < 2; ++nt) {
                    const int n0 = nt * 128;
                    gemm_dma<32, 2>(smem, t, 16, hbuf + (size_t)row0 * 1024, [&](int r) { return (unsigned)(r * 1024); }, 64,
                        Wr + (size_t)n0 * 1024, [&](int r) { return (unsigned)(r * 1024); },
                        [&](f32x4 (&acc)[1][4], int wr, int wc, int fr, int g) {
#pragma unroll
                            for (int n = 0; n < 4; ++n) {
                                const int tok = row0 + wr * 16 + fr, col = n0 + wc * 64 + n * 16 + 4 * g;
                                *(float4*)(logit + (size_t)tok * 256 + col) = make_float4(acc[0][n][0], acc[0][n][1], acc[0][n][2], acc[0][n][3]);
                            }
                        });
                }
                __syncthreads();
                for (int r = 0; r < 8; ++r) {
                    const int tok = row0 + wid * 8 + r;
                    const float4 lv = *(const float4*)(logit + (size_t)tok * 256 + lane * 4);
                    const float4 bv = *(const float4*)(rb + lane * 4);
                    const float s[4] = {sigmoidf_(lv.x), sigmoidf_(lv.y), sigmoidf_(lv.z), sigmoidf_(lv.w)};
                    const float ss[4] = {s[0] + bv.x, s[1] + bv.y, s[2] + bv.z, s[3] + bv.w};
                    float m1 = NEG_INF, m2 = NEG_INF;
#pragma unroll
                    for (int i = 0; i < 4; ++i) { if (ss[i] > m1) { m2 = m1; m1 = ss[i]; } else if (ss[i] > m2) m2 = ss[i]; }
                    { const float o1 = dppf<0xB1>(m1), o2 = dppf<0xB1>(m2); const float n1 = fmaxf(m1, o1), n2 = fmaxf(fminf(m1, o1), fmaxf(m2, o2)); m1 = n1; m2 = n2; }
                    { const float o1 = dppf<0x4E>(m1), o2 = dppf<0x4E>(m2); const float n1 = fmaxf(m1, o1), n2 = fmaxf(fminf(m1, o1), fmaxf(m2, o2)); m1 = n1; m2 = n2; }
                    { const float o1 = dppf<0x141>(m1), o2 = dppf<0x141>(m2); const float n1 = fmaxf(m1, o1), n2 = fmaxf(fminf(m1, o1), fmaxf(m2, o2)); m1 = n1; m2 = n2; }
                    const float gs = m1 + m2; const int gi = lane >> 3;
                    int rank = 0;
#pragma unroll
                    for (int gj = 0; gj < 8; ++gj) { const float og = __uint_as_float(__builtin_amdgcn_readlane(__float_as_uint(gs), gj * 8)); rank += (og > gs || (og == gs && gj < gi)) ? 1 : 0; }
                    const bool gsel = rank < 4;
                    u64_t key[4];
#pragma unroll
                    for (int i = 0; i < 4; ++i) { unsigned ub = __float_as_uint(ss[i]); ub ^= (ub >> 31) ? 0xFFFFFFFFu : 0x80000000u;
                        key[i] = gsel ? (((u64_t)ub << 32) | (0xFFFFFFFFu - (unsigned)(lane * 4 + i))) : 0ull; }
                    int my_e = 0; float my_s = 0.f;
                    for (int k = 0; k < 8; ++k) {
                        u64_t best = max64(max64(key[0], key[1]), max64(key[2], key[3]));
                        best = wave_max64(best);
                        const int bi = __builtin_amdgcn_readfirstlane((int)(0xFFFFFFFFu - (unsigned)best));
                        const int owner = bi >> 2, sub = bi & 3;
                        const float cand = (sub == 0) ? s[0] : (sub == 1) ? s[1] : (sub == 2) ? s[2] : s[3];
                        const float sval = __uint_as_float(__builtin_amdgcn_readlane(__float_as_uint(cand), owner));
#pragma unroll
                        for (int i = 0; i < 4; ++i) if (key[i] == best) key[i] = 0ull;
                        if (lane == k) { my_e = bi; my_s = sval; }
                    }
                    float tot = (lane < 8) ? my_s : 0.f;
                    tot += dppf<0xB1>(tot); tot += dppf<0x4E>(tot); tot += dppf<0x141>(tot);
                    if (lane < 8) {
                        const float w = my_s / tot * 2.5f;
                        ewb[(size_t)tok * 8 + lane] = w;
                        const unsigned pos = atomicAdd(&cnt[my_e * CSTR], 1u);
                        listb[(size_t)my_e * 16384 + pos] = tok * 8 + lane;
                    }
                }
                __syncthreads();
            }
        }
        GRID_BARRIER();

        int* tpre = (int*)(smem + 65536);
        int* rpre = tpre + 260;
        int* txp = tpre + 520;
        int* tx2 = txp + 264;
        { PHASE_BEGIN_L
            const unsigned* cnt = cntb + L * 256 * CSTR;
            int* cl = tpre;
            { int n = (int)cnt[t * CSTR]; n = n < 0 ? 0 : (n > 16384 ? 16384 : n); cl[t] = n; }
            __syncthreads();
            if (t == 0) { int ra = 0; for (int e = 0; e < 256; ++e) { rpre[e] = ra; ra += cl[e]; } rpre[256] = ra; }
            if (t >= 64 && t < 72) { const int x = t - 64; int ta = 0, tb = 0;
                for (int i = 0; i < 32; ++i) { txp[x * 33 + i] = ta; tx2[x * 33 + i] = tb; const int n = cl[x + 8 * i]; ta += (n + 127) >> 7; tb += (n + 255) >> 8; }
                txp[x * 33 + 32] = ta; tx2[x * 33 + 32] = tb; }
            __syncthreads();
        }
        { PHASE_BEGIN_L
            const int xg = bid & 7, xslot = bid >> 3, nslot = G >> 3;
            const int nXu = __builtin_amdgcn_readfirstlane(tx2[xg * 33 + 32] * 4);
            int shn = 0, shb = 0;
            {   int tot = 64;
                for (int x = 0; x < 8; ++x) tot += tx2[x * 33 + 32];
                const int tgt = (tot + 7) >> 3;
                int rem = 64, base = 0;
                for (int x = 0; x < 8; ++x) { int sx = tgt - tx2[x * 33 + 32]; sx = sx < 0 ? 0 : sx; sx = sx > rem ? rem : sx; if (x == 7) sx = rem;
                    if (x == xg) { shn = sx; shb = base; } base += sx; rem -= sx; }
                shn = __builtin_amdgcn_readfirstlane(shn); shb = __builtin_amdgcn_readfirstlane(shb); }
            for (int w = xslot; w < nXu + shn * 4; w += nslot) {
                int e, mt, ne, hoff, sub;
                if (w < nXu) { int lo = 0, hi = 31; while (lo < hi) { const int mid = (lo + hi + 1) >> 1; if (tx2[xg * 33 + mid] * 4 <= w) lo = mid; else hi = mid - 1; }
                    const int nte = tx2[xg * 33 + lo + 1] - tx2[xg * 33 + lo], li = w - tx2[xg * 33 + lo] * 4;
                    e = xg + 8 * lo; sub = li / nte; mt = li - sub * nte; ne = rpre[e + 1] - rpre[e]; hoff = rpre[e]; }
                else { const int w2 = w - nXu; e = 256; mt = shb + (w2 >> 2); sub = w2 & 3; ne = 16384; hoff = 131072; }
                e = __builtin_amdgcn_readfirstlane(e); mt = __builtin_amdgcn_readfirstlane(mt); ne = __builtin_amdgcn_readfirstlane(ne); hoff = __builtin_amdgcn_readfirstlane(hoff); sub = __builtin_amdgcn_readfirstlane(sub);
                const int j0 = sub * 64;
                const float* Wg = (e < 256) ? (p.exp_gate + ((size_t)L * 256 + e) * 262144) : (p.sh_gate + (size_t)L * 262144);
                const float* Wu = (e < 256) ? (p.exp_up + ((size_t)L * 256 + e) * 262144) : (p.sh_up + (size_t)L * 262144);
                const int* lst = listb + (size_t)e * 16384;
                gemm_f8_256(smem, t, 16, hb8,
                    [&](int r) { const int i = mt * 256 + r; if (i >= ne) return 0u;
                                 const int tok = (e < 256) ? (lst[i] >> 3) : i; return (unsigned)(tok * 1024); },
                    Wg + j0, Wu + j0, 256,
                    [&](f32x4 (&acc)[4][8], int wr, int fr, int g) {
#pragma unroll
                        for (int m = 0; m < 4; ++m) {
                            const int i = mt * 256 + wr * 64 + m * 16 + fr;
                            if (i < ne) {
                                const int tokq = (e < 256) ? (lst[i] >> 3) : i;
                                const float dq = __uint_as_float(((unsigned)hscl8[tokq] - 7u) << 23);
#pragma unroll
                                for (int n = 0; n < 8; ++n) acc[m][n] *= dq;
#pragma unroll
                                for (int k2 = 0; k2 < 2; ++k2) {
                                    float hv[8];
#pragma unroll
                                    for (int r = 0; r < 4; ++r) { hv[r] = siluf_(acc[m][2 * k2][r]) * acc[m][2 * k2 + 4][r]; hv[4 + r] = siluf_(acc[m][2 * k2 + 1][r]) * acc[m][2 * k2 + 5][r]; }
                                    uint4 o; o.x = pack2(hv[0], hv[1]); o.y = pack2(hv[2], hv[3]); o.z = pack2(hv[4], hv[5]); o.w = pack2(hv[6], hv[7]);
                                    *(uint4*)(hid + (size_t)(hoff + i) * 256 + j0 + k2 * 32 + 8 * g) = o;
                                }
                            }
                        }
                    });
            }
        }
        GRID_BARRIER();
        { PHASE_BEGIN_L
            const int xg = bid & 7, xslot = bid >> 3, nslot = G >> 3;
            const int fr = lane & 15, g = lane >> 4;
            const int ng = (t & 7) + 8 * ((t >> 4) & 1), kg = ((t >> 3) & 1) + 2 * (t >> 5);
            const int prow = ((((ng >> 3) & 1) * 2 + (ng & 1)) * 16) + 4 * ((ng >> 1) & 3);
            unsigned* hq = (unsigned*)(ws + 98304ull + ((size_t)L * 8 + xg) * 256);
            (void)xslot; (void)nslot;
            int hn = 0, hb = 0;
            {   int tot = 128;
                for (int x = 0; x < 8; ++x) tot += txp[x * 33 + 32];
                const int tgt = (tot + 7) >> 3;
                int rem = 64, base = 0;
                for (int x = 0; x < 8; ++x) { int sx = (tgt - txp[x * 33 + 32] + 1) >> 1; sx = sx < 0 ? 0 : sx; sx = sx > rem ? rem : sx; if (x == 7) sx = rem;
                    if (x == xg) { hn = sx; hb = base; } base += sx; rem -= sx; }
                hn = __builtin_amdgcn_readfirstlane(hn); hb = __builtin_amdgcn_readfirstlane(hb); }
            for (;;) {
                int w; Q_NEXT(hq, w);
                if (w >= 256 + hn * 8) break;
                int e, ntile, mt0, mt1, ne, hoff;
                if (w >= 256) { const int u2 = w - 256; e = 256; ntile = u2 & 7; mt0 = (hb + (u2 >> 3)) * 2; mt1 = mt0 + 2; ne = 16384; hoff = 131072; }
                else { const int w3 = w; e = xg + 8 * (w3 >> 3); ntile = w3 & 7; ne = __builtin_amdgcn_readfirstlane(rpre[e + 1] - rpre[e]); hoff = __builtin_amdgcn_readfirstlane(rpre[e]);
                       mt0 = 0; mt1 = (ne + 127) >> 7; }
                if (mt1 <= mt0) continue;
                const int n0 = ntile * 128;
                const float* Wd = ((e < 256) ? (p.exp_down + ((size_t)L * 256 + e) * 262144) : (p.sh_down + (size_t)L * 262144)) + n0;
                const int* lst = listb + (size_t)e * 16384;
                {
                    float4 bq[4][2][4];
#pragma unroll
                    for (int kq = 0; kq < 4; ++kq) { const float* p0 = Wd + (size_t)(kq * 64 + kg * 4) * 1024 + ng * 4;
#pragma unroll
                        for (int i = 0; i < 4; ++i) { bq[kq][0][i] = *(const float4*)(p0 + (size_t)i * 1024); bq[kq][1][i] = *(const float4*)(p0 + 64 + (size_t)i * 1024); } }
                    __builtin_amdgcn_sched_barrier(0);
#pragma unroll
                    for (int kq = 0; kq < 4; ++kq) { unsigned char* sB = smem + kq * 16384;
#pragma unroll
                        for (int pp = 0; pp < 2; ++pp) {
                            const float q0[4] = {bq[kq][pp][0].x, bq[kq][pp][0].y, bq[kq][pp][0].z, bq[kq][pp][0].w}, q1[4] = {bq[kq][pp][1].x, bq[kq][pp][1].y, bq[kq][pp][1].z, bq[kq][pp][1].w};
                            const float q2[4] = {bq[kq][pp][2].x, bq[kq][pp][2].y, bq[kq][pp][2].z, bq[kq][pp][2].w}, q3[4] = {bq[kq][pp][3].x, bq[kq][pp][3].y, bq[kq][pp][3].z, bq[kq][pp][3].w};
#pragma unroll
                            for (int i = 0; i < 4; ++i) { uint2 wv; wv.x = pack2(q0[i], q1[i]); wv.y = pack2(q2[i], q3[i]);
                                *(uint2*)(sB + swz(pp * 64 + prow + i, kg >> 1) + (kg & 1) * 8) = wv; }
                        } }
                }
                __syncthreads();
                for (int mt = mt0; mt < mt1; ++mt) {
                    int rowi[2], ent[2]; bf16_t* dstp[2]; float wgt[2];
                    bf16x8 afr[2][8];
#pragma unroll
                    for (int m = 0; m < 2; ++m) { rowi[m] = mt * 128 + wid * 32 + m * 16 + fr; ent[m] = (e < 256) ? lst[(rowi[m] < ne) ? rowi[m] : mt * 128] : rowi[m]; }
                    const bf16_t* ap0 = hid + (size_t)(hoff + ((rowi[0] < ne) ? rowi[0] : mt * 128)) * 256 + g * 8;
                    const bf16_t* ap1 = hid + (size_t)(hoff + ((rowi[1] < ne) ? rowi[1] : mt * 128)) * 256 + g * 8;
#pragma unroll
                    for (int ks = 0; ks < 8; ++ks) { afr[0][ks] = *(const bf16x8*)(ap0 + ks * 32); afr[1][ks] = *(const bf16x8*)(ap1 + ks * 32); }
#pragma unroll
                    for (int m = 0; m < 2; ++m) {
                        if (e < 256) { wgt[m] = ewb[ent[m]]; dstp[m] = (bf16_t*)(slot8 + (size_t)ent[m] * 1024); } else { wgt[m] = 1.f; dstp[m] = ysh + (size_t)rowi[m] * 1024; }
                    }
                    f32x4 acc[2][8];
#pragma unroll
                    for (int m = 0; m < 2; ++m)
#pragma unroll
                        for (int n = 0; n < 8; ++n) acc[m][n] = (f32x4){0.f, 0.f, 0.f, 0.f};
#pragma unroll
                    for (int kt = 0; kt < 4; ++kt) {
                        const unsigned char* sB = smem + kt * 16384;
#pragma unroll
                        for (int ks = 0; ks < 2; ++ks) {
#pragma unroll
                            for (int nh2 = 0; nh2 < 2; ++nh2) {
                                bf16x8 bfg[4];
#pragma unroll
                                for (int n = 0; n < 4; ++n) bfg[n] = *(const bf16x8*)(sB + swz((nh2 * 4 + n) * 16 + fr, ks * 4 + g));
#pragma unroll
                                for (int m = 0; m < 2; ++m)
#pragma unroll
                                    for (int n = 0; n < 4; ++n) acc[m][nh2 * 4 + n] = __builtin_amdgcn_mfma_f32_16x16x32_bf16(bfg[n], afr[m][2 * kt + ks], acc[m][nh2 * 4 + n], 0, 0, 0);
                                __builtin_amdgcn_sched_barrier(0);
                            }
                        }
                    }
#pragma unroll
                    for (int m = 0; m < 2; ++m) {
                        const float wsc = wgt[m];
                        if (e < 256) {
                            float am = 0.f;
#pragma unroll
                            for (int n = 0; n < 8; ++n) am = fmaxf(fmaxf(am, fmaxf(fabsf(acc[m][n][0]), fabsf(acc[m][n][1]))), fmaxf(fabsf(acc[m][n][2]), fabsf(acc[m][n][3])));
                            am = xr_max(am * wsc);
                            unsigned eb = (__float_as_uint(am) >> 23) & 255u; eb = eb < 8u ? 8u : eb;
                            const float qs = __uint_as_float((261u - eb) << 23) * wsc;
                            if (rowi[m] < ne) {
                                unsigned char* drow = (unsigned char*)dstp[m];
#pragma unroll
                                for (int hk = 0; hk < 4; ++hk) {
                                    int w0 = __builtin_amdgcn_cvt_pk_fp8_f32(acc[m][2 * hk][0] * qs, acc[m][2 * hk][1] * qs, 0, false);
                                    w0 = __builtin_amdgcn_cvt_pk_fp8_f32(acc[m][2 * hk][2] * qs, acc[m][2 * hk][3] * qs, w0, true);
                                    int w1 = __builtin_amdgcn_cvt_pk_fp8_f32(acc[m][2 * hk + 1][0] * qs, acc[m][2 * hk + 1][1] * qs, 0, false);
                                    w1 = __builtin_amdgcn_cvt_pk_fp8_f32(acc[m][2 * hk + 1][2] * qs, acc[m][2 * hk + 1][3] * qs, w1, true);
                                    uint2 o; o.x = (unsigned)w0; o.y = (unsigned)w1;
                                    *(uint2*)(drow + n0 + hk * 32 + 8 * g) = o;
                                }
                                if (g == 0) sscl[(size_t)ent[m] * 8 + ntile] = (unsigned char)eb;
                            }
                        } else if (rowi[m] < ne) {
#pragma unroll
                            for (int hk = 0; hk < 4; ++hk) {
                                uint4 o; o.x = pack2(acc[m][2 * hk][0] * wsc, acc[m][2 * hk][1] * wsc); o.y = pack2(acc[m][2 * hk][2] * wsc, acc[m][2 * hk][3] * wsc);
                                o.z = pack2(acc[m][2 * hk + 1][0] * wsc, acc[m][2 * hk + 1][1] * wsc); o.w = pack2(acc[m][2 * hk + 1][2] * wsc, acc[m][2 * hk + 1][3] * wsc);
                                *(uint4*)(dstp[m] + n0 + hk * 32 + 8 * g) = o;
                            }
                        }
                    }
                }
                __syncthreads();
            }
        }
        GRID_BARRIER();

        { PHASE_BEGIN_L
            const float* lg = p.ln_g + ((size_t)L * 2 + 1) * 1024, *lb = p.ln_b + ((size_t)L * 2 + 1) * 1024;
            const bool last = (L == NLAYER - 1);
            const float* modN = modb + (size_t)(L + 1) * 2 * 6144;
            for (int tok0 = (bid * 4 + wid) * 2; tok0 < NTOK; tok0 += G * 8) {
                float v[2][16]; float s[2] = {0.f, 0.f};
#pragma unroll
                for (int tt = 0; tt < 2; ++tt) {
                    const int tok = tok0 + tt, b = tok >> 13;
#pragma unroll
                    for (int i = 0; i < 4; ++i) {
                        const int d = i * 256 + lane * 4;
                        const uint2 xr = *(const uint2*)(xAh + (size_t)tok * 1024 + d);
                        const float4 xv = make_float4(bflo(xr.x), bfhi(xr.x), bflo(xr.y), bfhi(xr.y));
                        const float4 gf = *(const float4*)(modL + b * 6144 + 5120 + d);
                        const uint2 sy = *(const uint2*)(ysh + (size_t)tok * 1024 + d);
                        float y[4] = {bflo(sy.x), bfhi(sy.x), bflo(sy.y), bfhi(sy.y)};
                        unsigned sv[8]; uint2 sc8[8];
#pragma unroll
                        for (int k = 0; k < 8; ++k) { sv[k] = *(const unsigned*)(slot8 + ((size_t)tok * 8 + k) * 1024 + d); sc8[k] = *(const uint2*)(sscl + ((size_t)tok * 8 + k) * 8); }
                        const int ntl = i * 2 + (lane >> 5);
#pragma unroll
                        for (int k = 0; k < 8; ++k) {
                            const unsigned ew = (ntl < 4) ? sc8[k].x : sc8[k].y, eb = (ew >> ((ntl & 3) * 8)) & 255u;
                            const float inv = __uint_as_float((eb - 7u) << 23);
                            const auto f01 = __builtin_amdgcn_cvt_pk_f32_fp8((int)sv[k], false); const auto f23 = __builtin_amdgcn_cvt_pk_f32_fp8((int)sv[k], true);
                            y[0] += f01[0] * inv; y[1] += f01[1] * inv; y[2] += f23[0] * inv; y[3] += f23[1] * inv;
                        }
                        v[tt][i * 4 + 0] = ALPHA * xv.x + gf.x * y[0]; v[tt][i * 4 + 1] = ALPHA * xv.y + gf.y * y[1]; v[tt][i * 4 + 2] = ALPHA * xv.z + gf.z * y[2]; v[tt][i * 4 + 3] = ALPHA * xv.w + gf.w * y[3];
                        s[tt] += v[tt][i * 4] + v[tt][i * 4 + 1] + v[tt][i * 4 + 2] + v[tt][i * 4 + 3];
                    }
                }
#pragma unroll
                for (int tt = 0; tt < 2; ++tt) {
                    const int tok = tok0 + tt, b = tok >> 13;
                    const float mu = wave_sum(s[tt]) * (1.f / 1024.f);
                    float q = 0.f;
#pragma unroll
                    for (int i = 0; i < 16; ++i) { const float a = v[tt][i] - mu; q += a * a; }
                    q = wave_sum(q);
                    const float rs = rsqrtf(q * (1.f / 1024.f) + LN_EPS);
#pragma unroll
                    for (int i = 0; i < 4; ++i) {
                        const int d = i * 256 + lane * 4;
                        const float4 gg = *(const float4*)(lg + d), bb = *(const float4*)(lb + d);
                        float4 o; o.x = (v[tt][i * 4] - mu) * rs * gg.x + bb.x; o.y = (v[tt][i * 4 + 1] - mu) * rs * gg.y + bb.y; o.z = (v[tt][i * 4 + 2] - mu) * rs * gg.z + bb.z; o.w = (v[tt][i * 4 + 3] - mu) * rs * gg.w + bb.w;
                        if (last) *(float4*)(p.out + (size_t)tok * 1024 + d) = o;
                        else { uint2 xo2; xo2.x = pack2(o.x, o.y); xo2.y = pack2(o.z, o.w); *(uint2*)(xBh + (size_t)tok * 1024 + d) = xo2; }
                        if (!last) {
                            const float4 sh = *(const float4*)(modN + b * 6144 + d), sc = *(const float4*)(modN + b * 6144 + 1024 + d);
                            uint2 hh; hh.x = pack2(o.x * (1.f + sc.x) + sh.x, o.y * (1.f + sc.y) + sh.y); hh.y = pack2(o.z * (1.f + sc.z) + sh.z, o.w * (1.f + sc.w) + sh.w);
                            *(uint2*)(hbuf + (size_t)tok * 1024 + d) = hh;
                        }
                    }
                }
            }
        }
        if (Lrun + 1 < NLAYER) GRID_BARRIER();
    }
}

extern "C" void kernel_launch(void* const* d_in, const int* in_sizes, int n_in, void* d_out, int out_size, void* d_ws, size_t ws_size, hipStream_t stream) {
    (void)in_sizes; (void)n_in; (void)out_size;
    static int grid = 0;
    if (!grid) {
        int dev = 0, cus = 0, per_cu = 0;
        hipGetDevice(&dev);
        hipDeviceGetAttribute(&cus, hipDeviceAttributeMultiprocessorCount, dev);
        hipFuncSetAttribute((const void*)fwd_kernel, hipFuncAttributeMaxDynamicSharedMemorySize, SMEM_BYTES);
        hipOccupancyMaxActiveBlocksPerMultiprocessor(&per_cu, fwd_kernel, 256, SMEM_BYTES);
        if (per_cu < 1) per_cu = 1;
        grid = cus * (per_cu < 2 ? per_cu : 2);
    }
    if (ws_size < (size_t)WS_END) fprintf(stderr, "workspace too small: %zu < %llu\n", ws_size, (unsigned long long)WS_END);
    hipMemsetAsync(d_ws, 0, WS_ZERO_BYTES, stream);
    Params p{};
    const float** pp = (const float**)&p;
    for (int i = 0; i < 24; ++i) pp[i] = (const float*)d_in[i];
    p.out = (float*)d_out; p.ws = (unsigned char*)d_ws;
    hipLaunchKernelGGL(fwd_kernel, dim3(grid), dim3(256), SMEM_BYTES, stream, p);
}
```
